# Optimizing an MI355X kernel written in HIP

```python
import math
import jax, jax.numpy as jnp
from jax import lax
import numpy as np

D_MODEL = 2048
BATCH = 8
SEQ = 4096
DEPTH = 1
DEC_BATCH = 4
DEC_SEQ = 8192
PAST_LEN = 128

GRID_W = 64
MIX_WIDTH = D_MODEL
HY_WIDTH = MIX_WIDTH // 2
NAT_WIDTH = MIX_WIDTH - HY_WIDTH
HY_ORDER = 2
HY_SHORT = 3
HY_EMB = 33
HY_FILTER_HIDDEN = 64
HY_FAST_DECAY = 0.3
HY_SLOW_DECAY = 1.5
HY_DECAY_TARGET = 1e-2
NAT_HEADS = 16
NAT_HEAD_DIM = NAT_WIDTH // NAT_HEADS
NAT_KH_MAX = 8
NAT_KW = 16
D_FF = 4 * D_MODEL
NORM_EPS = 1e-5

kernel_name = "hymba_hyena_natten_encoder"


def rms_norm(x, g):
    xf = x.astype(jnp.float32)
    y = xf * lax.rsqrt(jnp.mean(xf * xf, axis=-1, keepdims=True) + NORM_EPS)
    return (y * g.astype(jnp.float32)).astype(x.dtype)


def short_conv(u, w, b):
    up = jnp.pad(u, ((0, 0), (1, 1), (0, 0)))
    return up[:, :-2] * w[0] + up[:, 1:-1] * w[1] + up[:, 2:] * w[2] + b


def hyena_filters(L, w1, b1, w2, b2, w3, b3, freq, w4):
    f32 = jnp.float32
    t = jnp.linspace(0.0, 1.0, L, dtype=f32)[:, None]
    bands = (HY_EMB - 1) // 2
    w_ang = (2.0 * math.pi / L) * jnp.arange(L, dtype=f32)
    f = jnp.linspace(1e-4, bands - 1, bands, dtype=f32)
    ang = w_ang[:, None] * f[None, :]
    z = jnp.concatenate([t, jnp.cos(ang), -jnp.sin(ang)], axis=-1)
    fr = freq.astype(f32)
    h = jnp.sin(fr * (z @ w1.astype(f32) + b1.astype(f32)))
    h = jnp.sin(fr * (h @ w2.astype(f32) + b2.astype(f32)))
    h = jnp.sin(fr * (h @ w3.astype(f32) + b3.astype(f32)))
    h = (h @ w4.astype(f32)).reshape(L, HY_ORDER, 2, HY_WIDTH)
    max_decay = math.log(HY_DECAY_TARGET) / HY_FAST_DECAY
    min_decay = math.log(HY_DECAY_TARGET) / HY_SLOW_DECAY
    deltas = jnp.linspace(min_decay, max_decay, HY_WIDTH, dtype=f32)
    decay = jnp.exp(-t * jnp.abs(deltas)[None, :])
    h = h * decay[:, None, None, :]
    h_fwd = h[:, :, 0]
    h_bwd = h[:, :, 1]
    k = jnp.concatenate([h_fwd, jnp.zeros((1, HY_ORDER, HY_WIDTH), f32), h_bwd[:0:-1]], axis=0)
    return jnp.fft.rfft(k, axis=0)


def hyena_mixer(u, k_hat, bias):
    L = u.shape[1]
    v, x1, x2 = jnp.split(u.astype(jnp.float32), 3, axis=-1)
    bias = bias.astype(jnp.float32)
    z = v
    for o, gate in enumerate((x1, x2)):
        z_hat = jnp.fft.rfft(z, n=2 * L, axis=1)
        conv = jnp.fft.irfft(z_hat * k_hat[:, o][None], n=2 * L, axis=1)[:, :L]
        z = gate * (conv + z * bias[o])
    return z.astype(u.dtype)


def neighborhood_attention(q, k, v, rpb):
    B, L, H, hd = q.shape
    rows = L // GRID_W
    kh = min(NAT_KH_MAX, rows)
    qg = q.reshape(B, rows, GRID_W, H, hd)
    kg = k.reshape(B, rows, GRID_W, H, hd)
    vg = v.reshape(B, rows, GRID_W, H, hd)
    cols = jnp.arange(GRID_W)
    col_start = jnp.clip(cols - NAT_KW // 2, 0, GRID_W - NAT_KW)
    col_idx = col_start[:, None] + jnp.arange(NAT_KW)[None, :]
    col_off = col_idx - cols[:, None] + (NAT_KW - 1)
    scale = hd ** -0.5

    def row_block(i):
        rs = jnp.clip(i - kh // 2, 0, rows - kh)
        q_row = lax.dynamic_index_in_dim(qg, i, axis=1, keepdims=False)
        k_rows = lax.dynamic_slice_in_dim(kg, rs, kh, axis=1)
        v_rows = lax.dynamic_slice_in_dim(vg, rs, kh, axis=1)
        k_win = k_rows[:, :, col_idx]
        v_win = v_rows[:, :, col_idx]
        s = jnp.einsum('bjhd,bajkhd->bhjak', q_row, k_win).astype(jnp.float32) * scale
        row_off = rs + jnp.arange(kh) - i + (NAT_KH_MAX - 1)
        bias = rpb[:, row_off][:, :, col_off]
        s = s + jnp.transpose(bias, (0, 2, 1, 3)).astype(jnp.float32)[None]
        p = jax.nn.softmax(s.reshape(B, H, GRID_W, kh * NAT_KW), axis=-1)
        p = p.reshape(B, H, GRID_W, kh, NAT_KW).astype(v.dtype)
        return jnp.einsum('bhjak,bajkhd->bjhd', p, v_win)

    out = lax.map(row_block, jnp.arange(rows))
    return jnp.moveaxis(out, 0, 1).reshape(B, L, H * hd)


def encoder_trunk(x, norm_mix_g, w_in, hy_conv_w, hy_conv_b, hy_pe_w1, hy_pe_b1, hy_pe_w2,
                  hy_pe_b2, hy_pe_w3, hy_pe_b3, hy_pe_freq, hy_pe_w4, hy_bias, nat_rpb,
                  gnorm_hy, gnorm_nat, w_out, norm_mlp_g, w_up, w_down, norm_f_g):
    B, L, _ = x.shape
    h = x
    for l in range(DEPTH):
        k_hat = hyena_filters(L, hy_pe_w1[l], hy_pe_b1[l], hy_pe_w2[l], hy_pe_b2[l],
                              hy_pe_w3[l], hy_pe_b3[l], hy_pe_freq[l], hy_pe_w4[l])
        a = rms_norm(h, norm_mix_g[l])
        proj = a @ w_in[l]
        u_hy = short_conv(proj[..., :3 * HY_WIDTH], hy_conv_w[l], hy_conv_b[l])
        y_hy = hyena_mixer(u_hy, k_hat, hy_bias[l])
        q, k, v = jnp.split(proj[..., 3 * HY_WIDTH:], 3, axis=-1)
        q = q.reshape(B, L, NAT_HEADS, NAT_HEAD_DIM)
        k = k.reshape(B, L, NAT_HEADS, NAT_HEAD_DIM)
        v = v.reshape(B, L, NAT_HEADS, NAT_HEAD_DIM)
        y_nat = neighborhood_attention(q, k, v, nat_rpb[l])
        mix = jnp.concatenate([rms_norm(y_hy, gnorm_hy[l]), rms_norm(y_nat, gnorm_nat[l])], axis=-1)
        h = h + mix @ w_out[l]
        m = rms_norm(h, norm_mlp_g[l])
        h = h + jnp.square(jax.nn.relu(m @ w_up[l])) @ w_down[l]
    return rms_norm(h, norm_f_g)


def setup_inputs(seed: int = 0) -> dict:
    key = jax.random.key(seed)
    ks = jax.random.split(key, 24)
    f32 = jnp.float32
    nrm = lambda k, shape, s: jax.random.normal(k, shape, f32) * s
    H2 = HY_FILTER_HIDDEN
    return {
        "x_prompt": jax.random.normal(ks[0], (BATCH, SEQ, D_MODEL), f32),
        "x_sample": jax.random.normal(ks[1], (DEC_BATCH, DEC_SEQ, D_MODEL), f32),
        "norm_mix_g": 1.0 + nrm(ks[2], (DEPTH, D_MODEL), 0.02),
        "w_in": nrm(ks[3], (DEPTH, D_MODEL, 6 * HY_WIDTH), D_MODEL ** -0.5),
        "hy_conv_w": nrm(ks[4], (DEPTH, HY_SHORT, 3 * HY_WIDTH), HY_SHORT ** -0.5),
        "hy_conv_b": nrm(ks[5], (DEPTH, 3 * HY_WIDTH), 0.02),
        "hy_pe_w1": nrm(ks[6], (DEPTH, HY_EMB, H2), HY_EMB ** -0.5),
        "hy_pe_b1": nrm(ks[7], (DEPTH, H2), 0.02),
        "hy_pe_w2": nrm(ks[8], (DEPTH, H2, H2), H2 ** -0.5),
        "hy_pe_b2": nrm(ks[9], (DEPTH, H2), 0.02),
        "hy_pe_w3": nrm(ks[10], (DEPTH, H2, H2), H2 ** -0.5),
        "hy_pe_b3": nrm(ks[11], (DEPTH, H2), 0.02),
        "hy_pe_freq": 1.0 + nrm(ks[12], (DEPTH, H2), 0.01),
        "hy_pe_w4": nrm(ks[13], (DEPTH, H2, HY_ORDER * 2 * HY_WIDTH), 0.1 * H2 ** -0.5),
        "hy_bias": nrm(ks[14], (DEPTH, HY_ORDER, HY_WIDTH), 1.0),
        "nat_rpb": nrm(ks[15], (DEPTH, NAT_HEADS, 2 * NAT_KH_MAX - 1, 2 * NAT_KW - 1), 0.02),
        "gnorm_hy": 1.0 + nrm(ks[16], (DEPTH, HY_WIDTH), 0.02),
        "gnorm_nat": 1.0 + nrm(ks[17], (DEPTH, NAT_WIDTH), 0.02),
        "w_out": nrm(ks[18], (DEPTH, MIX_WIDTH, D_MODEL), MIX_WIDTH ** -0.5),
        "norm_mlp_g": 1.0 + nrm(ks[19], (DEPTH, D_MODEL), 0.02),
        "w_up": nrm(ks[20], (DEPTH, D_MODEL, D_FF), D_MODEL ** -0.5),
        "w_down": nrm(ks[21], (DEPTH, D_FF, D_MODEL), D_FF ** -0.5),
        "norm_f_g": 1.0 + nrm(ks[22], (D_MODEL,), 0.02),
    }


def reference(x_prompt, x_sample, norm_mix_g, w_in, hy_conv_w, hy_conv_b, hy_pe_w1, hy_pe_b1,
              hy_pe_w2, hy_pe_b2, hy_pe_w3, hy_pe_b3, hy_pe_freq, hy_pe_w4, hy_bias, nat_rpb,
              gnorm_hy, gnorm_nat, w_out, norm_mlp_g, w_up, w_down, norm_f_g):
    weights = (norm_mix_g, w_in, hy_conv_w, hy_conv_b, hy_pe_w1, hy_pe_b1, hy_pe_w2, hy_pe_b2,
               hy_pe_w3, hy_pe_b3, hy_pe_freq, hy_pe_w4, hy_bias, nat_rpb, gnorm_hy, gnorm_nat,
               w_out, norm_mlp_g, w_up, w_down, norm_f_g)
    y_prompt = encoder_trunk(x_prompt, *weights)
    y_sample = encoder_trunk(x_sample, *weights)
    return (y_prompt, y_sample)
```

```cpp
#include <hip/hip_runtime.h>
#include <hip/hip_cooperative_groups.h>
#include <cstdio>
namespace cg = cooperative_groups;
namespace pg8 {
#define PG8_LAS __attribute__((address_space(3)))
typedef unsigned short bf16_t;
typedef short bf16x8 __attribute__((ext_vector_type(8)));
typedef float f32x4 __attribute__((ext_vector_type(4)));
typedef unsigned u32x4 __attribute__((ext_vector_type(4)));
constexpr int BM = 256, BK = 64, HALF = 128, HTB = HALF * BK * 2  , STAGE_BYTES = 8 * HTB, NXCD = 8, WGM = 8;

__host__ __device__ __forceinline__ int lds_byte(int r, int c) { const int st = (r >> 4) * 2 + (c >> 5), rr = r & 15, cc = c & 31, ob = rr * 64 + cc * 2; return st * 1024 + (ob ^ (((ob >> 9) & 1) << 5)); }
__host__ __device__ __forceinline__ void stage_rc(int b, int& R, int& C) { const int st = b / 1024, sb = b % 1024, swz = sb ^ (((sb >> 9) & 1) << 5); R = (st >> 1) * 16 + swz / 64; C = (st & 1) * 32 + (swz % 64) / 2; }
__host__ __device__ __forceinline__ int perm32(int rho) { const int n = rho >> 4, i = rho & 15; return 8 * (i >> 2) + 4 * n + (i & 3); }

struct Unit { int pm, pn; };
struct Gemm { const bf16_t* A; const bf16_t* Bt; int M, N, K; };

struct StaticOrder {
    int nM, nN, nwg, G, c;
    __host__ __device__ void init(int M, int N, int G_, int c_) { nM = M / BM; nN = N / BM; nwg = nM * nN; G = G_; c = c_; }
    __host__ __device__ bool next(int i, Unit& u) const {
        const long L = (long)i * G + c; if (L >= nwg) return false;
        int wgid = (int)L; { const int q = nwg / NXCD, r = nwg % NXCD, xcd = wgid % NXCD, off = wgid / NXCD; wgid = (xcd < r ? xcd * (q + 1) : r * (q + 1) + (xcd - r) * q) + off; }
        const int nig = WGM * nN, gid = wgid / nig, fm = gid * WGM, gsz = (nM - fm) < WGM ? (nM - fm) : WGM;
        u.pm = fm + ((wgid % nig) % gsz); u.pn = (wgid % nig) / gsz; return true;
    }
    __device__ __forceinline__ void a_ready(const Unit&) const {}
    __device__ __forceinline__ void done(const Unit&) const {}
};
__device__ __forceinline__ unsigned cvt_pk_bf16(float lo, float hi) { unsigned r; asm volatile("v_cvt_pk_bf16_f32 %0, %1, %2" : "=v"(r) : "v"(lo), "v"(hi)); return r; }
template <class Epi, class Sched, bool STAMP = false>
__device__ __forceinline__ void gemm_phase(PG8_LAS unsigned char* lds, const Gemm g, const Sched& S, const Epi& E, unsigned long long* stamps) {
    int tid_l = threadIdx.x; asm volatile("" : "+v"(tid_l));
    const int tid = tid_l, wid = __builtin_amdgcn_readfirstlane(tid >> 6), lane = tid & 63, wr = wid >> 2, wc = wid & 3, fr = lane & 15, fq = lane >> 4;
    const int K = g.K, nt = K / BK;
    int ts_lo = 0, ts_hi = 0, nts = 0; const unsigned long long rt_entry = STAMP ? (unsigned long long)wall_clock64() : 0ull;
#define PG8_STAMP() do { if (STAMP && wid == 0 && nts < 64) { const unsigned long long _c = (unsigned long long)clock64(); \
        ts_lo = (lane == nts) ? (int)(unsigned)_c : ts_lo; ts_hi = (lane == nts) ? (int)(unsigned)(_c >> 32) : ts_hi; ++nts; } } while (0)
    PG8_STAMP();
    unsigned voffA[2], voffB[2];
#pragma unroll
    for (int i = 0; i < 2; ++i) { int R, C; stage_rc(tid * 16 + i * 8192, R, C); const int Rb = Epi::PERM ? ((R & ~31) + perm32(R & 31)) : R;
        voffA[i] = (unsigned)(R * K + C) * 2u; voffB[i] = (unsigned)(Rb * K + C) * 2u; }
    const size_t kstep = (size_t)(BK * 2);
    const size_t hstep = (size_t)HALF * K * 2;
    const size_t tstep = 2 * hstep;
    const unsigned ldsw = (unsigned)wid * 1024u;
    const int aoff = lds_byte(wr * 64 + fr, fq * 8), boff = lds_byte(wc * 32 + fr, fq * 8);
#define PG8_SA(b, h) (((b) * 2 + (h)) * HTB)
#define PG8_SB(b, h) ((4 + (b) * 2 + (h)) * HTB)
#define PG8_STAGE(bufoff, gbase, voff) do { _Pragma("unroll") for (int _i = 0; _i < 2; ++_i) \
        __builtin_amdgcn_global_load_lds((const unsigned*)((const char*)(gbase) + (voff)[_i]), (PG8_LAS unsigned*)(lds + (bufoff) + ldsw + _i * 8192), 16, 0, 0); } while (0)
#define PG8_LDA(dst, b, h) do { _Pragma("unroll") for (int m = 0; m < 4; ++m) _Pragma("unroll") for (int k = 0; k < 2; ++k) dst[m][k] = *(const PG8_LAS bf16x8*)(lds + PG8_SA(b, h) + aoff + m * 2048 + k * 1024); } while (0)
#define PG8_LDB(dst, b, h) do { _Pragma("unroll") for (int n = 0; n < 2; ++n) _Pragma("unroll") for (int k = 0; k < 2; ++k) dst[n][k] = *(const PG8_LAS bf16x8*)(lds + PG8_SB(b, h) + boff + n * 2048 + k * 1024); } while (0)
#define PG8_MMA(ai, bj, At, Bt) do { __builtin_amdgcn_s_setprio(1); _Pragma("unroll") for (int m = 0; m < 4; ++m) _Pragma("unroll") for (int n = 0; n < 2; ++n) _Pragma("unroll") for (int k = 0; k < 2; ++k) \
        acc[ai][bj][m][n] = __builtin_amdgcn_mfma_f32_16x16x32_bf16(Bt[n][k], At[m][k], acc[ai][bj][m][n], 0, 0, 0); __builtin_amdgcn_s_setprio(0); } while (0)
#define PG8_WAIT_V(n) asm volatile("s_waitcnt vmcnt(" #n ")" ::: "memory")
#define PG8_WAIT_L(n) asm volatile("s_waitcnt lgkmcnt(" #n ")" ::: "memory")
#define PG8_BAR __builtin_amdgcn_s_barrier()
#define PG8_SCHED __builtin_amdgcn_sched_barrier(0)
    Unit cur, nxt; int ui = 0;
    if (!S.next(0, cur)) return;
    f32x4 acc[2][2][4][2];
#pragma unroll
    for (int a = 0; a < 2; ++a)
#pragma unroll
        for (int b = 0; b < 2; ++b)
#pragma unroll
            for (int m = 0; m < 4; ++m)
#pragma unroll
                for (int n = 0; n < 2; ++n) acc[a][b][m][n] = (f32x4){0.f, 0.f, 0.f, 0.f};
    bf16x8 At[4][2], B0[2][2], B1[2][2];
    const char* cA = (const char*)g.A + (size_t)cur.pm * tstep; const char* cB = (const char*)g.Bt + (size_t)cur.pn * tstep;
    S.a_ready(cur);
    PG8_STAGE(PG8_SB(0, 0), cB, voffB); PG8_STAGE(PG8_SA(0, 0), cA, voffA); PG8_STAGE(PG8_SB(0, 1), cB + hstep, voffB); PG8_STAGE(PG8_SA(0, 1), cA + hstep, voffA);
    if (wr == 1) PG8_BAR;
    PG8_WAIT_V(4); PG8_BAR;
    PG8_STAGE(PG8_SB(1, 0), cB + kstep, voffB); PG8_STAGE(PG8_SA(1, 0), cA + kstep, voffA); PG8_STAGE(PG8_SB(1, 1), cB + hstep + kstep, voffB);
    PG8_WAIT_V(6); PG8_BAR;
    PG8_STAMP();
    for (;;) {
        const bool has_next = S.next(ui + 1, nxt);
        const char* nA = has_next ? (const char*)g.A + (size_t)nxt.pm * tstep : cA; const char* nB = has_next ? (const char*)g.Bt + (size_t)nxt.pn * tstep : cB;
        for (int t = 0; t < nt; t += 2) {
            const bool last = (t == nt - 2);
            const char* a1 = cA + (size_t)(t + 1) * kstep;
            const char* a2 = last ? nA : cA + (size_t)(t + 2) * kstep; const char* b2 = last ? nB : cB + (size_t)(t + 2) * kstep;
            const char* a3 = a2 + kstep; const char* b3 = b2 + kstep;
            if (last && has_next) S.a_ready(nxt);
            PG8_LDB(B0, 0, 0); PG8_SCHED; PG8_LDA(At, 0, 0); PG8_STAGE(PG8_SA(1, 1), a1 + hstep, voffA);
            PG8_WAIT_L(8); PG8_BAR; PG8_WAIT_L(0); PG8_MMA(0, 0, At, B0); PG8_BAR; PG8_SCHED;
            PG8_LDB(B1, 0, 1); PG8_STAGE(PG8_SB(0, 0), b2, voffB);
            PG8_BAR; PG8_WAIT_L(0); PG8_MMA(0, 1, At, B1); PG8_BAR;
            PG8_LDA(At, 0, 1); PG8_STAGE(PG8_SA(0, 0), a2, voffA);
            PG8_BAR; PG8_WAIT_L(0); PG8_MMA(1, 0, At, B0); PG8_BAR; PG8_SCHED;
            PG8_STAGE(PG8_SB(0, 1), b2 + hstep, voffB);
            PG8_WAIT_V(6); PG8_BAR; PG8_MMA(1, 1, At, B1); PG8_BAR;
            PG8_LDB(B0, 1, 0); PG8_SCHED; PG8_LDA(At, 1, 0); PG8_STAGE(PG8_SA(0, 1), a2 + hstep, voffA);
            PG8_WAIT_L(8); PG8_BAR; PG8_WAIT_L(0); PG8_MMA(0, 0, At, B0); PG8_BAR; PG8_SCHED;
            PG8_LDB(B1, 1, 1); PG8_STAGE(PG8_SB(1, 0), b3, voffB);
            PG8_BAR; PG8_WAIT_L(0); PG8_MMA(0, 1, At, B1); PG8_BAR;
            PG8_LDA(At, 1, 1); PG8_STAGE(PG8_SA(1, 0), a3, voffA);
            PG8_BAR; PG8_WAIT_L(0); PG8_MMA(1, 0, At, B0); PG8_BAR; PG8_SCHED;
            PG8_STAGE(PG8_SB(1, 1), b3 + hstep, voffB);
            PG8_WAIT_V(6); PG8_BAR; PG8_MMA(1, 1, At, B1); PG8_BAR;
        }
        PG8_STAMP();
        if constexpr (!Epi::AFTER_DRAIN) { E(acc, cur, wr, wc, fr, fq); S.done(cur); }
        PG8_STAMP();
        if (!has_next) break;
#pragma unroll
        for (int a = 0; a < 2; ++a)
#pragma unroll
            for (int b = 0; b < 2; ++b)
#pragma unroll
                for (int m = 0; m < 4; ++m)
#pragma unroll
                    for (int n = 0; n < 2; ++n) acc[a][b][m][n] = (f32x4){0.f, 0.f, 0.f, 0.f};
        cur = nxt; cA = nA; cB = nB; ++ui;
    }
    PG8_WAIT_V(0);
    if (wr == 0) PG8_BAR;
    PG8_BAR;
    if constexpr (Epi::AFTER_DRAIN) { E.fused(acc, cur, wr, wc, fr, fq, lds, wid, lane); S.done(cur); }
    PG8_STAMP();
    if (STAMP && wid == 0) { stamps[lane] = lane < nts ? (((unsigned long long)(unsigned)ts_hi << 32) | (unsigned)ts_lo) : 0ull;
        if (lane == 62) stamps[62] = rt_entry; if (lane == 63) stamps[63] = (unsigned long long)wall_clock64(); }
#undef PG8_STAMP
#undef PG8_SA
#undef PG8_SB
#undef PG8_STAGE
#undef PG8_LDA
#undef PG8_LDB
#undef PG8_MMA
#undef PG8_WAIT_V
#undef PG8_WAIT_L
#undef PG8_BAR
#undef PG8_SCHED
}
}

#define LAS __attribute__((address_space(3)))
typedef unsigned short bf16_t;
typedef float f32x4 __attribute__((ext_vector_type(4)));
typedef unsigned u32x4 __attribute__((ext_vector_type(4)));
typedef unsigned u32x2 __attribute__((ext_vector_type(2)));
typedef short bf16x8 __attribute__((ext_vector_type(8)));
typedef short bf16x4 __attribute__((ext_vector_type(4)));

constexpr int NTOK = 65536, DM = 2048, NPROMPT = 32768, DFF = 8192;
constexpr float EPS = 1e-5f;
constexpr size_t MiB = 1u << 20;
constexpr size_t WS_RSTDX = 0, WS_SSH = 256 * 1024, WS_SSF = 512 * 1024, WS_TW = 768 * 1024;
constexpr size_t WS_H3A = 1 * MiB, WS_H3B = 2 * MiB;
constexpr size_t WS_WIN = 4 * MiB, WS_WOUT = 28 * MiB, WS_WUP = 36 * MiB, WS_WDN = 68 * MiB, WS_KH = 100 * MiB, WS_UT = 164 * MiB, WS_QKV = 548 * MiB, WS_ZA = 932 * MiB, WS_END = 964 * MiB;
constexpr size_t WS_MIX = WS_UT, WS_HB = WS_QKV, WS_HID = WS_UT;
constexpr size_t DO_XB = 0, DO_YT = 256 * MiB, DO_YNAT = 384 * MiB;
constexpr int LDS_BYTES = 147456;
constexpr int FFN_CHUNK = 16384, N_CHUNK = NTOK / FFN_CHUNK;
constexpr int N_PHASES = 5 + 2 * N_CHUNK + 1;

struct Params { const float* in[23]; float* out; unsigned char* ws; int ph_lo, ph_hi; };

__device__ __forceinline__ float wave_sum(float v) {
#pragma unroll
    for (int o = 1; o < 64; o <<= 1) v += __shfl_xor(v, o);
    return v;
}
__device__ __forceinline__ unsigned pk2(float lo, float hi) { return pg8::cvt_pk_bf16(lo, hi); }
__device__ __forceinline__ float bf2f(unsigned short b) { return __uint_as_float(((unsigned)b) << 16); }
__device__ __forceinline__ float bflo(unsigned w) { return __uint_as_float(w << 16); }
__device__ __forceinline__ float bfhi(unsigned w) { return __uint_as_float(w & 0xffff0000u); }

struct EpiUT {
    static constexpr bool PERM = true, AFTER_DRAIN = false;
    bf16_t* O; const float* rstd;
    __device__ __forceinline__ void operator()(const f32x4 (&acc)[2][2][4][2], const pg8::Unit& u, int wr, int wc, int fr, int fq) const {
        const int row0 = u.pm * 256 + wr * 64 + fr, col0 = u.pn * 256 + wc * 32 + 8 * fq;
        f32x4 s[2][2];
#pragma unroll
        for (int bj = 0; bj < 2; ++bj) { s[bj][0] = *(const f32x4*)(rstd + col0 + bj * 128); s[bj][1] = *(const f32x4*)(rstd + col0 + bj * 128 + 4); }
#pragma unroll
        for (int ai = 0; ai < 2; ++ai)
#pragma unroll
            for (int m = 0; m < 4; ++m) { bf16_t* rowp = O + (size_t)(row0 + ai * 128 + m * 16) * NTOK + col0;
#pragma unroll
                for (int bj = 0; bj < 2; ++bj) { const f32x4 v0 = acc[ai][bj][m][0] * s[bj][0], v1 = acc[ai][bj][m][1] * s[bj][1];
                    u32x4 w; w.x = pk2(v0[0], v0[1]); w.y = pk2(v0[2], v0[3]); w.z = pk2(v1[0], v1[1]); w.w = pk2(v1[2], v1[3]);
                    *(u32x4*)(rowp + bj * 128) = w; } }
    }
};
struct EpiQKV {
    static constexpr bool PERM = true, AFTER_DRAIN = false;
    bf16_t* O; const float* rstd;
    __device__ __forceinline__ void operator()(const f32x4 (&acc)[2][2][4][2], const pg8::Unit& u, int wr, int wc, int fr, int fq) const {
        const int row0 = u.pm * 256 + wr * 64 + fr, col0 = u.pn * 256 + wc * 32 + 8 * fq;
#pragma unroll
        for (int ai = 0; ai < 2; ++ai)
#pragma unroll
            for (int m = 0; m < 4; ++m) { const int row = row0 + ai * 128 + m * 16; const float s = rstd[row]; bf16_t* rowp = O + (size_t)row * 3072 + col0;
#pragma unroll
                for (int bj = 0; bj < 2; ++bj) { const f32x4 v0 = acc[ai][bj][m][0] * s, v1 = acc[ai][bj][m][1] * s;
                    u32x4 w; w.x = pk2(v0[0], v0[1]); w.y = pk2(v0[2], v0[3]); w.z = pk2(v1[0], v1[1]); w.w = pk2(v1[2], v1[3]);
                    *(u32x4*)(rowp + bj * 128) = w; } }
    }
};
struct EpiH {
    static constexpr bool PERM = true, AFTER_DRAIN = false;
    const float* xp; const float* xs; float* H; bf16_t* HB; float* ss;
    __device__ __forceinline__ void operator()(const f32x4 (&acc)[2][2][4][2], const pg8::Unit& u, int wr, int wc, int fr, int fq) const {
        const int row0 = u.pm * 256 + wr * 64 + fr, col0 = u.pn * 256 + wc * 32 + 8 * fq;
#pragma unroll
        for (int ai = 0; ai < 2; ++ai)
#pragma unroll
            for (int m = 0; m < 4; ++m) { const int row = row0 + ai * 128 + m * 16;
                const float* xr = (row < NPROMPT ? xp + (size_t)row * DM : xs + (size_t)(row - NPROMPT) * DM) + col0;
                float* hr = H + (size_t)row * DM + col0; bf16_t* br = HB + (size_t)row * DM + col0; float q = 0.f;
#pragma unroll
                for (int bj = 0; bj < 2; ++bj) { const f32x4 x0 = *(const f32x4*)(xr + bj * 128), x1 = *(const f32x4*)(xr + bj * 128 + 4);
                    const f32x4 v0 = acc[ai][bj][m][0] + x0, v1 = acc[ai][bj][m][1] + x1;
                    *(f32x4*)(hr + bj * 128) = v0; *(f32x4*)(hr + bj * 128 + 4) = v1;
                    u32x4 w; w.x = pk2(v0[0], v0[1]); w.y = pk2(v0[2], v0[3]); w.z = pk2(v1[0], v1[1]); w.w = pk2(v1[2], v1[3]);
                    *(u32x4*)(br + bj * 128) = w;
                    q += (v0[0] * v0[0] + v0[1] * v0[1]) + (v0[2] * v0[2] + v0[3] * v0[3]) + (v1[0] * v1[0] + v1[1] * v1[1]) + (v1[2] * v1[2] + v1[3] * v1[3]); }
                q += __shfl_xor(q, 16); q += __shfl_xor(q, 32);
                if (fq == 0) atomicAdd(ss + row, q);
                asm volatile("" ::: "memory"); }
    }
};
struct EpiUp {
    static constexpr bool PERM = true, AFTER_DRAIN = false;
    bf16_t* O; const float* ss;
    __device__ __forceinline__ void operator()(const f32x4 (&acc)[2][2][4][2], const pg8::Unit& u, int wr, int wc, int fr, int fq) const {
        const int row0 = u.pm * 256 + wr * 64 + fr, col0 = u.pn * 256 + wc * 32 + 8 * fq;
#pragma unroll
        for (int ai = 0; ai < 2; ++ai)
#pragma unroll
            for (int m = 0; m < 4; ++m) { const int row = row0 + ai * 128 + m * 16; const float s = 1.0f / sqrtf(ss[row] * (1.0f / DM) + EPS); bf16_t* rowp = O + (size_t)row * DFF + col0;
#pragma unroll
                for (int bj = 0; bj < 2; ++bj) { f32x4 v0 = acc[ai][bj][m][0] * s, v1 = acc[ai][bj][m][1] * s;
#pragma unroll
                    for (int e = 0; e < 4; ++e) { const float a = fmaxf(v0[e], 0.f), b = fmaxf(v1[e], 0.f); v0[e] = a * a; v1[e] = b * b; }
                    u32x4 w; w.x = pk2(v0[0], v0[1]); w.y = pk2(v0[2], v0[3]); w.z = pk2(v1[0], v1[1]); w.w = pk2(v1[2], v1[3]);
                    *(u32x4*)(rowp + bj * 128) = w; } }
    }
};
struct EpiDown {
    static constexpr bool PERM = true, AFTER_DRAIN = false;
    float* H; float* ss;
    __device__ __forceinline__ void operator()(const f32x4 (&acc)[2][2][4][2], const pg8::Unit& u, int wr, int wc, int fr, int fq) const {
        const int row0 = u.pm * 256 + wr * 64 + fr, col0 = u.pn * 256 + wc * 32 + 8 * fq;
#pragma unroll
        for (int ai = 0; ai < 2; ++ai)
#pragma unroll
            for (int m = 0; m < 4; ++m) { const int row = row0 + ai * 128 + m * 16; float* hr = H + (size_t)row * DM + col0; float q = 0.f;
#pragma unroll
                for (int bj = 0; bj < 2; ++bj) { const f32x4 x0 = *(const f32x4*)(hr + bj * 128), x1 = *(const f32x4*)(hr + bj * 128 + 4);
                    const f32x4 v0 = acc[ai][bj][m][0] + x0, v1 = acc[ai][bj][m][1] + x1;
                    *(f32x4*)(hr + bj * 128) = v0; *(f32x4*)(hr + bj * 128 + 4) = v1;
                    q += (v0[0] * v0[0] + v0[1] * v0[1]) + (v0[2] * v0[2] + v0[3] * v0[3]) + (v1[0] * v1[0] + v1[1] * v1[1]) + (v1[2] * v1[2] + v1[3] * v1[3]); }
                q += __shfl_xor(q, 16); q += __shfl_xor(q, 32);
                if (fq == 0) atomicAdd(ss + row, q);
                asm volatile("" ::: "memory"); }
    }
};

__device__ __forceinline__ void transpose_item(const float* W, const float* g, int K, int N, bf16_t* WT, float* scr, int item, int lane) {
    const int nblk = N / 32, kb = item / nblk, nb = item % nblk, k0 = 64 * kb, n0 = 32 * nb;
#pragma unroll 8
    for (int i = 0; i < 32; ++i) { const int kk = 2 * i + (lane >> 5); const float sc = g ? g[k0 + kk] : 1.0f; scr[kk * 33 + (lane & 31)] = W[(size_t)(k0 + kk) * N + n0 + (lane & 31)] * sc; }
    __builtin_amdgcn_s_waitcnt(0); __builtin_amdgcn_wave_barrier();
    const int c = lane & 7;
#pragma unroll
    for (int j = 0; j < 4; ++j) { const int n = (lane >> 3) + 8 * j; const float* s = scr + (8 * c) * 33 + n;
        u32x4 o; o.x = pk2(s[0 * 33], s[1 * 33]); o.y = pk2(s[2 * 33], s[3 * 33]); o.z = pk2(s[4 * 33], s[5 * 33]); o.w = pk2(s[6 * 33], s[7 * 33]);
        *(u32x4*)(WT + (size_t)(n0 + n) * K + k0 + 8 * c) = o; }
    __builtin_amdgcn_s_waitcnt(0); __builtin_amdgcn_wave_barrier();
}

__device__ __forceinline__ void phase_prep(const Params& p, unsigned char* lds_raw) {
    unsigned char* ws = p.ws;
    const int tid = threadIdx.x, lane = tid & 63, wave = tid >> 6;
    const int gw = blockIdx.x * 8 + wave, NGW = gridDim.x * 8;
    const int gt = blockIdx.x * 512 + tid, NGT = gridDim.x * 512;
    { float* z1 = (float*)(ws + WS_SSH); float* z2 = (float*)(ws + WS_SSF);
      for (int i = gt; i < NTOK; i += NGT) { z1[i] = 0.f; z2[i] = 0.f; } }
    { float2* T = (float2*)(ws + WS_TW);
      for (int j = gt; j < 8192; j += NGT) { float s, c; sincospif((float)j * (1.0f / 8192.0f), &s, &c); T[j] = make_float2(c, -s); } }
    { bf16_t* xb = (bf16_t*)((unsigned char*)p.out + DO_XB); float* rstd = (float*)(ws + WS_RSTDX);
      for (int row = gw; row < NTOK; row += NGW) {
          const float* xr = row < NPROMPT ? p.in[0] + (size_t)row * DM : p.in[1] + (size_t)(row - NPROMPT) * DM;
          f32x4 v[8]; float s = 0.f;
#pragma unroll
          for (int j = 0; j < 8; ++j) { v[j] = ((const f32x4*)xr)[lane + 64 * j]; s += (v[j][0] * v[j][0] + v[j][1] * v[j][1]) + (v[j][2] * v[j][2] + v[j][3] * v[j][3]); }
          s = wave_sum(s);
          if (lane == 0) rstd[row] = 1.0f / sqrtf(s * (1.0f / DM) + EPS);
          u32x2* o = (u32x2*)(xb + (size_t)row * DM);
#pragma unroll
          for (int j = 0; j < 8; ++j) { u32x2 w; w.x = pk2(v[j][0], v[j][1]); w.y = pk2(v[j][2], v[j][3]); o[lane + 64 * j] = w; }
      } }
    { float* scr = (float*)(lds_raw + wave * 16384);
      constexpr int I_IN = (DM / 64) * (6144 / 32), I_OUT = (DM / 64) * (DM / 32), I_UP = (DM / 64) * (DFF / 32), I_DN = (DFF / 64) * (DM / 32);
      for (int it = gw; it < I_IN + I_OUT + I_UP + I_DN; it += NGW) {
          int r = it;
          if (r < I_IN) { transpose_item(p.in[3], p.in[2], DM, 6144, (bf16_t*)(ws + WS_WIN), scr, r, lane); continue; } r -= I_IN;
          if (r < I_OUT) { transpose_item(p.in[18], nullptr, DM, DM, (bf16_t*)(ws + WS_WOUT), scr, r, lane); continue; } r -= I_OUT;
          if (r < I_UP) { transpose_item(p.in[20], p.in[19], DM, DFF, (bf16_t*)(ws + WS_WUP), scr, r, lane); continue; } r -= I_UP;
          transpose_item(p.in[21], nullptr, DFF, DM, (bf16_t*)(ws + WS_WDN), scr, r, lane);
      } }
    { const float* w1 = p.in[6]; const float* b1 = p.in[7]; const float* w2 = p.in[8]; const float* b2 = p.in[9]; const float* w3 = p.in[10]; const float* b3 = p.in[11]; const float* fr = p.in[12];
      const float frl = fr[lane];
      for (int it = gw; it < 4096 + 8192; it += NGW) {
          int L, t; float* h3;
          if (it < 4096) { L = 4096; t = it; h3 = (float*)(ws + WS_H3A); } else { L = 8192; t = it - 4096; h3 = (float*)(ws + WS_H3B); }
          const float tl = (float)t / (float)(L - 1);
          const float wang = (6.283185307179586f / (float)L) * (float)t;
          float a = tl * w1[lane];
#pragma unroll 4
          for (int b = 0; b < 16; ++b) { const float f = 1e-4f + (float)b * ((15.0f - 1e-4f) / 15.0f); const float ang = wang * f;
              a += cosf(ang) * w1[(1 + b) * 64 + lane]; a -= sinf(ang) * w1[(17 + b) * 64 + lane]; }
          float h = sinf(frl * (a + b1[lane]));
          a = 0.f;
#pragma unroll 8
          for (int i = 0; i < 64; ++i) a += __shfl(h, i) * w2[i * 64 + lane];
          h = sinf(frl * (a + b2[lane]));
          a = 0.f;
#pragma unroll 8
          for (int i = 0; i < 64; ++i) a += __shfl(h, i) * w3[i * 64 + lane];
          h = sinf(frl * (a + b3[lane]));
          h3[(size_t)t * 64 + lane] = h;
      } }
}

template <int LOG>
__device__ __forceinline__ void fft_fwd(float2* D, const float2* TL, int tid) {
    constexpr int L = 1 << LOG;
#pragma unroll 1
    for (int s = LOG - 1; s >= 0; --s) {
        const int half = 1 << s;
#pragma unroll
        for (int jj = 0; jj < L / 1024; ++jj) {
            const int j = tid + 512 * jj, pos = j & (half - 1), i0 = ((j >> s) << (s + 1)) | pos, i1 = i0 + half;
            const float2 a = D[i0], b = D[i1], w = TL[pos << (LOG - 1 - s)];
            D[i0] = make_float2(a.x + b.x, a.y + b.y);
            const float tx = a.x - b.x, ty = a.y - b.y;
            D[i1] = make_float2(tx * w.x - ty * w.y, tx * w.y + ty * w.x);
        }
        __syncthreads();
    }
}
template <int LOG>
__device__ __forceinline__ void fft_inv(float2* D, const float2* TL, int tid) {
    constexpr int L = 1 << LOG;
#pragma unroll 1
    for (int s = 0; s < LOG; ++s) {
        const int half = 1 << s;
#pragma unroll
        for (int jj = 0; jj < L / 1024; ++jj) {
            const int j = tid + 512 * jj, pos = j & (half - 1), i0 = ((j >> s) << (s + 1)) | pos, i1 = i0 + half;
            const float2 a = D[i0], b = D[i1], w = TL[pos << (LOG - 1 - s)];
            const float bx = b.x * w.x + b.y * w.y, by = b.y * w.x - b.x * w.y;
            D[i0] = make_float2(a.x + bx, a.y + by);
            D[i1] = make_float2(a.x - bx, a.y - by);
        }
        __syncthreads();
    }
}
__device__ __forceinline__ float sconv(const bf16_t* base, int n, int L, float w0, float w1, float w2, float b) {
    const float l = n > 0 ? bf2f(base[n - 1]) : 0.f, m = bf2f(base[n]), r = n < L - 1 ? bf2f(base[n + 1]) : 0.f;
    return w0 * l + w1 * m + w2 * r + b;
}
template <int LOG>
__device__ __forceinline__ void hyena_item(const Params& p, int c, unsigned char* lds_raw) {
    constexpr int L = 1 << LOG, NE = L / 512, MS = 13 - LOG;
    constexpr int NB = (LOG == 13) ? 4 : 8, TOK0 = (LOG == 13) ? NPROMPT : 0;
    unsigned char* ws = p.ws;
    float2* D = (float2*)lds_raw; float2* TL = (float2*)(lds_raw + 65536); float* W4C = (float*)(lds_raw + 98304);
    const float2* T = (const float2*)(ws + WS_TW);
    const float* h3 = (const float*)(ws + (LOG == 13 ? WS_H3B : WS_H3A));
    float2* Kb = (float2*)(ws + WS_KH + (size_t)blockIdx.x * 262144);
    float2* Zg = (float2*)(ws + WS_ZA + (size_t)blockIdx.x * 131072); float2* Ag = Zg + L;
    const bf16_t* uT = (const bf16_t*)(ws + WS_UT);
    bf16_t* yT = (bf16_t*)((unsigned char*)p.out + DO_YT);
    const float* convw = p.in[4]; const float* convb = p.in[5]; const float* w4 = p.in[13]; const float* hbias = p.in[14];
    const int tid = threadIdx.x;
    for (int k = tid; k < L / 2; k += 512) TL[k] = T[k << (14 - LOG)];
    if (tid < 256) { const int j = tid >> 2, q = tid & 3; W4C[tid] = w4[(size_t)j * 4096 + (q >> 1) * 2048 + (q & 1) * 1024 + c]; }
    __syncthreads();
    const float adel = 3.0701134573253945f + (float)c * (12.280453829301578f / 1023.0f);
#pragma unroll 1
    for (int o = 0; o < 2; ++o) {
        float* HF = (float*)D; float* HBk = HF + L;
#pragma unroll 1
        for (int i = 0; i < NE; ++i) { const int n = tid + 512 * i; const f32x4* hr = (const f32x4*)(h3 + (size_t)n * 64); float a0 = 0.f, a1 = 0.f;
#pragma unroll
            for (int j4 = 0; j4 < 16; ++j4) { const f32x4 hv = hr[j4];
#pragma unroll
                for (int e = 0; e < 4; ++e) { a0 += hv[e] * W4C[(j4 * 4 + e) * 4 + o * 2]; a1 += hv[e] * W4C[(j4 * 4 + e) * 4 + o * 2 + 1]; } }
            const float dec = expf(-((float)n / (float)(L - 1)) * adel);
            HF[n] = a0 * dec; HBk[n] = a1 * dec; }
        __syncthreads();
#pragma unroll 2
        for (int i = 0; i < NE; ++i) { const int n = tid + 512 * i; Ag[n] = make_float2(HF[n], n ? HBk[L - n] : 0.f); }
        __syncthreads();
        const float bo = hbias[o * 1024 + c];
#pragma unroll 2
        for (int i = 0; i < NE; ++i) { const int n = tid + 512 * i; const float2 v = Ag[n]; D[n] = make_float2(v.x + v.y, 0.f); }
        __syncthreads();
        fft_fwd<LOG>(D, TL, tid);
#pragma unroll 2
        for (int i = 0; i < NE; ++i) { const int n = tid + 512 * i; float2 v = D[n]; v.x += bo; Kb[(size_t)(o * 2 + 0) * L + n] = v; }
        __syncthreads();
#pragma unroll 2
        for (int i = 0; i < NE; ++i) { const int n = tid + 512 * i; const float2 w = T[n << MS]; const float2 hv = Ag[n]; const float v = hv.x - hv.y; D[n] = make_float2(v * w.x, v * w.y); }
        __syncthreads();
        fft_fwd<LOG>(D, TL, tid);
#pragma unroll 2
        for (int i = 0; i < NE; ++i) { const int n = tid + 512 * i; float2 v = D[n]; v.x += bo; Kb[(size_t)(o * 2 + 1) * L + n] = v; }
        __syncthreads();
    }
    const float inv2L = 1.0f / (float)(2 * L);
#pragma unroll 1
    for (int pr = 0; pr < NB / 2; ++pr) {
        const size_t tbase = (size_t)TOK0 + (size_t)(2 * pr) * L;
        { const bf16_t* b0 = uT + (size_t)c * NTOK + tbase; const bf16_t* b1 = b0 + L;
          const float w0 = convw[c], w1 = convw[3072 + c], w2 = convw[6144 + c], bb = convb[c];
#pragma unroll 2
          for (int i = 0; i < NE; ++i) { const int n = tid + 512 * i; Zg[n] = make_float2(sconv(b0, n, L, w0, w1, w2, bb), sconv(b1, n, L, w0, w1, w2, bb)); } }
        __syncthreads();
#pragma unroll 1
        for (int o = 0; o < 2; ++o) {
            const float2* K0 = Kb + (size_t)(o * 2 + 0) * L; const float2* K1 = Kb + (size_t)(o * 2 + 1) * L;
#pragma unroll 2
            for (int i = 0; i < NE; ++i) { const int n = tid + 512 * i; D[n] = Zg[n]; }
            __syncthreads();
            fft_fwd<LOG>(D, TL, tid);
#pragma unroll 2
            for (int i = 0; i < NE; ++i) { const int n = tid + 512 * i; const float2 k = K0[n], d = D[n]; D[n] = make_float2(d.x * k.x - d.y * k.y, d.x * k.y + d.y * k.x); }
            __syncthreads();
            fft_inv<LOG>(D, TL, tid);
#pragma unroll 2
            for (int i = 0; i < NE; ++i) { const int n = tid + 512 * i; Ag[n] = D[n]; }
            __syncthreads();
#pragma unroll 2
            for (int i = 0; i < NE; ++i) { const int n = tid + 512 * i; const float2 w = T[n << MS], z = Zg[n]; D[n] = make_float2(z.x * w.x - z.y * w.y, z.x * w.y + z.y * w.x); }
            __syncthreads();
            fft_fwd<LOG>(D, TL, tid);
#pragma unroll 2
            for (int i = 0; i < NE; ++i) { const int n = tid + 512 * i; const float2 k = K1[n], d = D[n]; D[n] = make_float2(d.x * k.x - d.y * k.y, d.x * k.y + d.y * k.x); }
            __syncthreads();
            fft_inv<LOG>(D, TL, tid);
            { const int gc = (o + 1) * 1024 + c; const bf16_t* g0 = uT + (size_t)gc * NTOK + tbase; const bf16_t* g1 = g0 + L;
              const float w0 = convw[gc], w1 = convw[3072 + gc], w2 = convw[6144 + gc], bb = convb[gc];
#pragma unroll 2
              for (int i = 0; i < NE; ++i) { const int n = tid + 512 * i; const float2 w = T[n << MS], d = D[n]; float2 a = Ag[n];
                  a.x += d.x * w.x + d.y * w.y; a.y += d.y * w.x - d.x * w.y;
                  Zg[n] = make_float2(sconv(g0, n, L, w0, w1, w2, bb) * (a.x * inv2L), sconv(g1, n, L, w0, w1, w2, bb) * (a.y * inv2L)); } }
            __syncthreads();
        }
        { bf16_t* y0 = yT + (size_t)c * NTOK + tbase; bf16_t* y1 = y0 + L;
#pragma unroll 2
          for (int i = 0; i < NE; ++i) { const int n = tid + 512 * i; const float2 z = Zg[n]; y0[n] = (bf16_t)(pk2(z.x, 0.f) & 0xffffu); y1[n] = (bf16_t)(pk2(z.y, 0.f) & 0xffffu); } }
        __syncthreads();
    }
}

constexpr int VP = 524;
__device__ __forceinline__ void nat_item(const Params& p, int idx, unsigned char* lds_raw) {
    unsigned char* ws = p.ws;
    const bf16_t* qkv = (const bf16_t*)(ws + WS_QKV);
    bf16_t* ynat = (bf16_t*)((unsigned char*)p.out + DO_YNAT);
    const float* rpb = p.in[15];
    bf16_t* VT = (bf16_t*)lds_raw;
    const int tid = threadIdx.x;
    int i, hp, rows, tok0;
    if (idx < 4096) { const int bg = idx >> 9, rem = idx & 511; i = rem >> 3; hp = rem & 7; rows = 64; tok0 = bg * 4096; }
    else { const int x = idx - 4096, bg = x >> 10, rem = x & 1023; i = rem >> 3; hp = rem & 7; rows = 128; tok0 = NPROMPT + bg * 8192; }
    const int rs = min(max(i - 4, 0), rows - 8);
#pragma unroll 4
    for (int it = 0; it < 16; ++it) {
        const int q = tid + 512 * it, tokl = q >> 4, ch = q & 15;
        const u32x4 v = *(const u32x4*)(qkv + (size_t)(tok0 + rs * 64 + tokl) * 3072 + 2048 + hp * 128 + ch * 8);
        bf16_t* dst = VT + (size_t)(ch * 8) * VP + tokl;
        dst[0 * VP] = (bf16_t)(v.x & 0xffffu); dst[1 * VP] = (bf16_t)(v.x >> 16);
        dst[2 * VP] = (bf16_t)(v.y & 0xffffu); dst[3 * VP] = (bf16_t)(v.y >> 16);
        dst[4 * VP] = (bf16_t)(v.z & 0xffffu); dst[5 * VP] = (bf16_t)(v.z >> 16);
        dst[6 * VP] = (bf16_t)(v.w & 0xffffu); dst[7 * VP] = (bf16_t)(v.w >> 16);
    }
    __syncthreads();
    const int w = tid >> 6, lane = tid & 63, r = lane & 15, q = lane >> 4;
    const int hl = w >> 2, jt = w & 3, head = hp * 2 + hl;
    const int sp = (jt == 0) ? 0 : (jt == 1) ? 8 : (jt == 2) ? 24 : 32;
    const int j = jt * 16 + r;
    const size_t tq = (size_t)tok0 + (size_t)i * 64 + j;
    const bf16_t* qp = qkv + tq * 3072 + head * 64 + q * 8;
    const bf16x8 qf0 = *(const bf16x8*)qp, qf1 = *(const bf16x8*)(qp + 32);
    const int cs = min(max(j - 8, 0), 48);
    float sc[8][2][4];
    float mx = -1e30f;
#pragma unroll
    for (int kr = 0; kr < 8; ++kr) {
        const float* bp = rpb + (size_t)(head * 15 + (rs + kr - i + 7)) * 31;
#pragma unroll
        for (int ct = 0; ct < 2; ++ct) {
            const bf16_t* kp = qkv + (size_t)(tok0 + (rs + kr) * 64 + sp + ct * 16 + r) * 3072 + 1024 + head * 64 + q * 8;
            const bf16x8 k0 = *(const bf16x8*)kp, k1 = *(const bf16x8*)(kp + 32);
            f32x4 s = {0.f, 0.f, 0.f, 0.f};
            s = __builtin_amdgcn_mfma_f32_16x16x32_bf16(k0, qf0, s, 0, 0, 0);
            s = __builtin_amdgcn_mfma_f32_16x16x32_bf16(k1, qf1, s, 0, 0, 0);
#pragma unroll
            for (int e = 0; e < 4; ++e) {
                const int col = sp + ct * 16 + 4 * q + e; const bool valid = (col >= cs) && (col <= cs + 15);
                const int co = min(max(col - j + 15, 0), 30);
                const float v = valid ? (s[e] * 0.125f + bp[co]) : -1e30f;
                sc[kr][ct][e] = v; mx = fmaxf(mx, v);
            }
        }
    }
    mx = fmaxf(mx, __shfl_xor(mx, 16)); mx = fmaxf(mx, __shfl_xor(mx, 32));
    float sum = 0.f;
#pragma unroll
    for (int kr = 0; kr < 8; ++kr)
#pragma unroll
        for (int ct = 0; ct < 2; ++ct)
#pragma unroll
            for (int e = 0; e < 4; ++e) { const float pv = exp2f((sc[kr][ct][e] - mx) * 1.4426950408889634f); sc[kr][ct][e] = pv; sum += pv; }
    sum += __shfl_xor(sum, 16); sum += __shfl_xor(sum, 32);
    f32x4 acc[4];
#pragma unroll
    for (int dt = 0; dt < 4; ++dt) acc[dt] = (f32x4){0.f, 0.f, 0.f, 0.f};
#pragma unroll
    for (int kr = 0; kr < 8; ++kr) {
        u32x4 pw; pw.x = pk2(sc[kr][0][0], sc[kr][0][1]); pw.y = pk2(sc[kr][0][2], sc[kr][0][3]); pw.z = pk2(sc[kr][1][0], sc[kr][1][1]); pw.w = pk2(sc[kr][1][2], sc[kr][1][3]);
        const bf16x8 pb = __builtin_bit_cast(bf16x8, pw);
#pragma unroll
        for (int dt = 0; dt < 4; ++dt) {
            const bf16_t* vp = VT + (size_t)(hl * 64 + dt * 16 + r) * VP + kr * 64 + sp + 4 * q;
            const u32x2 lo = *(const u32x2*)vp, hi = *(const u32x2*)(vp + 16);
            u32x4 vw; vw.x = lo.x; vw.y = lo.y; vw.z = hi.x; vw.w = hi.y;
            acc[dt] = __builtin_amdgcn_mfma_f32_16x16x32_bf16(__builtin_bit_cast(bf16x8, vw), pb, acc[dt], 0, 0, 0);
        }
    }
    const float inv = 1.0f / sum;
    bf16_t* op = ynat + tq * 1024 + head * 64 + 4 * q;
#pragma unroll
    for (int dt = 0; dt < 4; ++dt) { u32x2 o; o.x = pk2(acc[dt][0] * inv, acc[dt][1] * inv); o.y = pk2(acc[dt][2] * inv, acc[dt][3] * inv); *(u32x2*)(op + dt * 16) = o; }
    __syncthreads();
}

__device__ __forceinline__ void norm_item(const Params& p, int item, unsigned char* lds_raw) {
    unsigned char* ws = p.ws;
    const bf16_t* yT = (const bf16_t*)((unsigned char*)p.out + DO_YT);
    const bf16_t* ynat = (const bf16_t*)((unsigned char*)p.out + DO_YNAT);
    bf16_t* mix = (bf16_t*)(ws + WS_MIX);
    const float* ghy = p.in[16]; const float* gnat = p.in[17];
    bf16_t* Tl = (bf16_t*)lds_raw;
    const int tid = threadIdx.x, lane = tid & 63, w = tid >> 6;
    const int tokb = item * 64;
#pragma unroll 4
    for (int it = 0; it < 16; ++it) {
        const int q = tid + 512 * it, c = q >> 3, ch = q & 7;
        const u32x4 v = *(const u32x4*)(yT + (size_t)c * NTOK + tokb + ch * 8);
        unsigned* dst = (unsigned*)(Tl + c * 66 + ch * 8);
        dst[0] = v.x; dst[1] = v.y; dst[2] = v.z; dst[3] = v.w;
    }
    __syncthreads();
#pragma unroll 1
    for (int tt = 0; tt < 8; ++tt) {
        const int tl = w * 8 + tt; const size_t tok = (size_t)tokb + tl;
        float v[16]; float ss = 0.f;
#pragma unroll
        for (int jj = 0; jj < 16; ++jj) { v[jj] = bf2f(Tl[(lane + 64 * jj) * 66 + tl]); ss += v[jj] * v[jj]; }
        ss = wave_sum(ss);
        const float rstd = 1.0f / sqrtf(ss * (1.0f / 1024.0f) + EPS);
        bf16_t* mo = mix + tok * 2048;
#pragma unroll
        for (int jj = 0; jj < 16; ++jj) { const int c = lane + 64 * jj; mo[c] = (bf16_t)(pk2(v[jj] * rstd * ghy[c], 0.f) & 0xffffu); }
        const u32x4* src = (const u32x4*)(ynat + tok * 1024);
        u32x4 a[2]; a[0] = src[lane]; a[1] = src[lane + 64];
        float f[16]; float s2 = 0.f;
#pragma unroll
        for (int h = 0; h < 2; ++h) { f[h * 8 + 0] = bflo(a[h].x); f[h * 8 + 1] = bfhi(a[h].x); f[h * 8 + 2] = bflo(a[h].y); f[h * 8 + 3] = bfhi(a[h].y);
            f[h * 8 + 4] = bflo(a[h].z); f[h * 8 + 5] = bfhi(a[h].z); f[h * 8 + 6] = bflo(a[h].w); f[h * 8 + 7] = bfhi(a[h].w); }
#pragma unroll
        for (int e = 0; e < 16; ++e) s2 += f[e] * f[e];
        s2 = wave_sum(s2);
        const float r2 = 1.0f / sqrtf(s2 * (1.0f / 1024.0f) + EPS);
        u32x4* dst = (u32x4*)(mo + 1024);
#pragma unroll
        for (int h = 0; h < 2; ++h) { const f32x4 g0 = *(const f32x4*)(gnat + h * 512 + lane * 8), g1 = *(const f32x4*)(gnat + h * 512 + lane * 8 + 4);
            u32x4 o; o.x = pk2(f[h * 8 + 0] * r2 * g0[0], f[h * 8 + 1] * r2 * g0[1]); o.y = pk2(f[h * 8 + 2] * r2 * g0[2], f[h * 8 + 3] * r2 * g0[3]);
            o.z = pk2(f[h * 8 + 4] * r2 * g1[0], f[h * 8 + 5] * r2 * g1[1]); o.w = pk2(f[h * 8 + 6] * r2 * g1[2], f[h * 8 + 7] * r2 * g1[3]);
            dst[lane + 64 * h] = o; }
    }
    __syncthreads();
}

__global__ void __launch_bounds__(512, 2) fwd_kernel(Params p) {
    extern __shared__ __attribute__((aligned(16))) unsigned char lds_raw[];
    cg::grid_group grid = cg::this_grid();
    LAS unsigned char* lds = (LAS unsigned char*)lds_raw;
    unsigned char* ws = p.ws;
    const int lo = p.ph_lo, hi = p.ph_hi;
    const int G = gridDim.x, bx = blockIdx.x;
#ifndef PHMASK
#define PHMASK 0xFFFFFF
#endif
#define IN(k) (((PHMASK >> (k)) & 1) && lo <= (k) && (k) < hi)
#define SEAM(k) do { if ((k) + 1 < hi) grid.sync(); } while (0)
    bf16_t* xb = (bf16_t*)((unsigned char*)p.out + DO_XB);
    float* rstdx = (float*)(ws + WS_RSTDX); float* ssh = (float*)(ws + WS_SSH); float* ssf = (float*)(ws + WS_SSF);

    if (IN(0)) { phase_prep(p, lds_raw); SEAM(0); }
    if (IN(1)) {
        { pg8::Gemm g{(const bf16_t*)(ws + WS_WIN), xb, 3072, NTOK, DM}; pg8::StaticOrder S; S.init(3072, NTOK, G, bx);
          EpiUT E{(bf16_t*)(ws + WS_UT), rstdx};
          pg8::gemm_phase<EpiUT, pg8::StaticOrder, false>(lds, g, S, E, nullptr); }
        { pg8::Gemm g{xb, (const bf16_t*)(ws + WS_WIN) + (size_t)3072 * DM, NTOK, 3072, DM}; pg8::StaticOrder S; S.init(NTOK, 3072, G, bx);
          EpiQKV E{(bf16_t*)(ws + WS_QKV), rstdx};
          pg8::gemm_phase<EpiQKV, pg8::StaticOrder, false>(lds, g, S, E, nullptr); }
        SEAM(1);
    }
    if (IN(2)) {
#ifndef NO_HY12
        for (int it = bx; it < 1024; it += G) hyena_item<12>(p, it, lds_raw);
#endif
#ifndef NO_HY13
        for (int it = bx; it < 1024; it += G) hyena_item<13>(p, it, lds_raw);
#endif
#ifndef NO_NAT
        for (int it = bx; it < 8192; it += G) nat_item(p, it, lds_raw);
#endif
        SEAM(2);
    }
    if (IN(3)) { for (int it = bx; it < 1024; it += G) norm_item(p, it, lds_raw); SEAM(3); }
    if (IN(4)) {
        pg8::Gemm g{(const bf16_t*)(ws + WS_MIX), (const bf16_t*)(ws + WS_WOUT), NTOK, DM, DM}; pg8::StaticOrder S; S.init(NTOK, DM, G, bx);
        EpiH E{p.in[0], p.in[1], p.out, (bf16_t*)(ws + WS_HB), ssh};
        pg8::gemm_phase<EpiH, pg8::StaticOrder, false>(lds, g, S, E, nullptr);
        SEAM(4);
    }
#pragma unroll 1
    for (int ck = 0; ck < N_CHUNK; ++ck) {
        if (IN(5 + 2 * ck)) {
            pg8::Gemm g{(const bf16_t*)(ws + WS_HB) + (size_t)ck * FFN_CHUNK * DM, (const bf16_t*)(ws + WS_WUP), FFN_CHUNK, DFF, DM}; pg8::StaticOrder S; S.init(FFN_CHUNK, DFF, G, bx);
            EpiUp E{(bf16_t*)(ws + WS_HID), ssh + ck * FFN_CHUNK};
            pg8::gemm_phase<EpiUp, pg8::StaticOrder, false>(lds, g, S, E, nullptr);
            SEAM(5 + 2 * ck);
        }
        if (IN(6 + 2 * ck)) {
            pg8::Gemm g{(const bf16_t*)(ws + WS_HID), (const bf16_t*)(ws + WS_WDN), FFN_CHUNK, DM, DFF}; pg8::StaticOrder S; S.init(FFN_CHUNK, DM, G, bx);
            EpiDown E{p.out + (size_t)ck * FFN_CHUNK * DM, ssf + ck * FFN_CHUNK};
            pg8::gemm_phase<EpiDown, pg8::StaticOrder, false>(lds, g, S, E, nullptr);
            SEAM(6 + 2 * ck);
        }
    }
    if (IN(N_PHASES - 1)) {
        const int tid = threadIdx.x, lane = tid & 63, gw = bx * 8 + (tid >> 6), NGW = G * 8;
        const f32x4* gf = (const f32x4*)p.in[22];
        for (int row = gw; row < NTOK; row += NGW) {
            f32x4* o = (f32x4*)(p.out + (size_t)row * DM);
            const float rs = 1.0f / sqrtf(ssf[row] * (1.0f / DM) + EPS);
#pragma unroll
            for (int j = 0; j < 8; ++j) { const f32x4 v = o[lane + 64 * j]; const f32x4 gg = gf[lane + 64 * j]; o[lane + 64 * j] = v * rs * gg; }
        }
    }
#undef IN
#undef SEAM
}

extern "C" void kernel_launch(void* const* d_in, const int* in_sizes, int n_in, void* d_out, int out_size, void* d_ws, size_t ws_size, hipStream_t stream) {
    static int grid = 0;
    if (grid == 0) {
        int dev = 0, cus = 0, per_cu = 0;
        hipGetDevice(&dev);
        hipDeviceGetAttribute(&cus, hipDeviceAttributeMultiprocessorCount, dev);
        hipFuncSetAttribute((const void*)fwd_kernel, hipFuncAttributeMaxDynamicSharedMemorySize, LDS_BYTES);
        hipOccupancyMaxActiveBlocksPerMultiprocessor(&per_cu, (const void*)fwd_kernel, 512, LDS_BYTES);
        (void)hipGetLastError();
        grid = cus > 0 ? cus : 256; if (grid > 256) grid = 256;
        if (n_in != 23 || ws_size < WS_END) { fprintf(stderr, "kernel_launch: unexpected n_in %d / ws_size %zu (need %zu)\n", n_in, ws_size, (size_t)WS_END); }
        fprintf(stderr, "kernel_launch: grid %d, occupancy query %d/CU, ws %zu\n", grid, per_cu, ws_size);
    }
    Params p{};
    for (int i = 0; i < 23; ++i) p.in[i] = (const float*)d_in[i];
    p.out = (float*)d_out; p.ws = (unsigned char*)d_ws; p.ph_lo = 0; p.ph_hi = N_PHASES;
    void* args[] = {&p};
    hipError_t e = hipLaunchCooperativeKernel((const void*)fwd_kernel, dim3(grid), dim3(512), args, LDS_BYTES, stream);
    if (e != hipSuccess) fprintf(stderr, "cooperative launch failed: %s (grid %d)\n", hipGetErrorString(e), grid);
}
```

```cpp
#include <hip/hip_runtime.h>
#include <hip/hip_cooperative_groups.h>
#include <cstdio>
namespace cg = cooperative_groups;
namespace pg8 {
#define PG8_LAS __attribute__((address_space(3)))
typedef unsigned short bf16_t;
typedef short bf16x8 __attribute__((ext_vector_type(8)));
typedef float f32x4 __attribute__((ext_vector_type(4)));
typedef unsigned u32x4 __attribute__((ext_vector_type(4)));
constexpr int PADK = 64;
constexpr int BM = 256, BK = 64, HALF = 128, HTB = HALF * BK * 2  , STAGE_BYTES = 8 * HTB, NXCD = 8, WGM = 8;

__host__ __device__ __forceinline__ int lds_byte(int r, int c) { const int st = (r >> 4) * 2 + (c >> 5), rr = r & 15, cc = c & 31, ob = rr * 64 + cc * 2; return st * 1024 + (ob ^ (((ob >> 9) & 1) << 5)); }
__host__ __device__ __forceinline__ void stage_rc(int b, int& R, int& C) { const int st = b / 1024, sb = b % 1024, swz = sb ^ (((sb >> 9) & 1) << 5); R = (st >> 1) * 16 + swz / 64; C = (st & 1) * 32 + (swz % 64) / 2; }
__host__ __device__ __forceinline__ int perm32(int rho) { const int n = rho >> 4, i = rho & 15; return 8 * (i >> 2) + 4 * n + (i & 3); }

struct Unit { int pm, pn; };
struct Gemm { const bf16_t* A; const bf16_t* Bt; int M, N, K; };

struct StaticOrder {
    int nM, nN, nwg, G, c;
    __host__ __device__ void init(int M, int N, int G_, int c_) { nM = M / BM; nN = N / BM; nwg = nM * nN; G = G_; c = c_; }
    __host__ __device__ bool next(int i, Unit& u) const {
        const long L = (long)i * G + c; if (L >= nwg) return false;
        int wgid = (int)L; { const int q = nwg / NXCD, r = nwg % NXCD, xcd = wgid % NXCD, off = wgid / NXCD; wgid = (xcd < r ? xcd * (q + 1) : r * (q + 1) + (xcd - r) * q) + off; }
        const int nig = WGM * nN, gid = wgid / nig, fm = gid * WGM, gsz = (nM - fm) < WGM ? (nM - fm) : WGM;
        u.pm = fm + ((wgid % nig) % gsz); u.pn = (wgid % nig) / gsz; return true;
    }
    __device__ __forceinline__ void a_ready(const Unit&) const {}
    __device__ __forceinline__ void done(const Unit&) const {}
};
__device__ __forceinline__ unsigned cvt_pk_bf16(float lo, float hi) { unsigned r; asm volatile("v_cvt_pk_bf16_f32 %0, %1, %2" : "=v"(r) : "v"(lo), "v"(hi)); return r; }
template <class Epi, class Sched, bool ALIGN_EPI = false, bool SP2 = false>
__device__ __forceinline__ void gemm_phase(PG8_LAS unsigned char* lds, const Gemm g, const Sched& S, const Epi& E) {
    int tid_l = threadIdx.x; asm volatile("" : "+v"(tid_l));
    const int tid = tid_l, wid = __builtin_amdgcn_readfirstlane(tid >> 6), lane = tid & 63, wr = wid >> 2, wc = wid & 3, fr = lane & 15, fq = lane >> 4;
    const int K = g.K, nt = K / BK;
    unsigned voffA[2], voffB[2];
#pragma unroll
    for (int i = 0; i < 2; ++i) { int R, C; stage_rc(tid * 16 + i * 8192, R, C); const int Rb = Epi::PERM ? ((R & ~31) + perm32(R & 31)) : R;
        voffA[i] = (unsigned)(R * (K + PADK) + C) * 2u; voffB[i] = (unsigned)(Rb * (K + PADK) + C) * 2u; }
    const size_t kstep = (size_t)(BK * 2);
    const size_t hstep = (size_t)HALF * (K + PADK) * 2;
    const size_t tstep = 2 * hstep;
    const unsigned ldsw = (unsigned)wid * 1024u;
    const int aoff = lds_byte(wr * 64 + fr, fq * 8), boff = lds_byte(wc * 32 + fr, fq * 8);
#define PG8_SA(b, h) (((b) * 2 + (h)) * HTB)
#define PG8_SB(b, h) ((4 + (b) * 2 + (h)) * HTB)
#define PG8_STAGE(bufoff, gbase, voff) do { _Pragma("unroll") for (int _i = 0; _i < 2; ++_i) \
        __builtin_amdgcn_global_load_lds((const unsigned*)((const char*)(gbase) + (voff)[_i]), (PG8_LAS unsigned*)(lds + (bufoff) + ldsw + _i * 8192), 16, 0, 0); } while (0)
#define PG8_LDA(dst, b, h) do { _Pragma("unroll") for (int m = 0; m < 4; ++m) _Pragma("unroll") for (int k = 0; k < 2; ++k) dst[m][k] = *(const PG8_LAS bf16x8*)(lds + PG8_SA(b, h) + aoff + m * 2048 + k * 1024); } while (0)
#define PG8_LDB(dst, b, h) do { _Pragma("unroll") for (int n = 0; n < 2; ++n) _Pragma("unroll") for (int k = 0; k < 2; ++k) dst[n][k] = *(const PG8_LAS bf16x8*)(lds + PG8_SB(b, h) + boff + n * 2048 + k * 1024); } while (0)
#define PG8_MMA(ai, bj, At, Bt) do { __builtin_amdgcn_s_setprio(1); _Pragma("unroll") for (int m = 0; m < 4; ++m) _Pragma("unroll") for (int n = 0; n < 2; ++n) _Pragma("unroll") for (int k = 0; k < 2; ++k) \
        acc[ai][bj][m][n] = __builtin_amdgcn_mfma_f32_16x16x32_bf16(Bt[n][k], At[m][k], acc[ai][bj][m][n], 0, 0, 0); __builtin_amdgcn_s_setprio(0); } while (0)
#define PG8_WAIT_V(n) asm volatile("s_waitcnt vmcnt(" #n ")" ::: "memory")
#define PG8_WAIT_L(n) asm volatile("s_waitcnt lgkmcnt(" #n ")" ::: "memory")
#define PG8_BAR __builtin_amdgcn_s_barrier()
#define PG8_SCHED __builtin_amdgcn_sched_barrier(0)
    Unit cur, nxt; int ui = 0;
    if (!S.next(0, cur)) return;
    f32x4 acc[2][2][4][2];
#pragma unroll
    for (int a = 0; a < 2; ++a)
#pragma unroll
        for (int b = 0; b < 2; ++b)
#pragma unroll
            for (int m = 0; m < 4; ++m)
#pragma unroll
                for (int n = 0; n < 2; ++n) acc[a][b][m][n] = (f32x4){0.f, 0.f, 0.f, 0.f};
    bf16x8 At[4][2], B0[2][2], B1[2][2];
    const char* cA = (const char*)g.A + (size_t)cur.pm * tstep; const char* cB = (const char*)g.Bt + (size_t)cur.pn * tstep;
    S.a_ready(cur);
    if constexpr (SP2) {
        PG8_STAGE(PG8_SB(0, 0), cB, voffB); PG8_STAGE(PG8_SB(0, 1), cB + hstep, voffB); PG8_STAGE(PG8_SA(0, 0), cA, voffA); PG8_STAGE(PG8_SA(0, 1), cA + hstep, voffA);
        if (wr == 1) PG8_BAR;
        PG8_WAIT_V(2); PG8_BAR;
        PG8_STAGE(PG8_SB(1, 0), cB + kstep, voffB); PG8_STAGE(PG8_SA(1, 0), cA + kstep, voffA); PG8_STAGE(PG8_SB(1, 1), cB + hstep + kstep, voffB);
        PG8_WAIT_V(6); PG8_BAR;
    } else {
        PG8_STAGE(PG8_SB(0, 0), cB, voffB); PG8_STAGE(PG8_SA(0, 0), cA, voffA); PG8_STAGE(PG8_SB(0, 1), cB + hstep, voffB); PG8_STAGE(PG8_SA(0, 1), cA + hstep, voffA);
        if (wr == 1) PG8_BAR;
        PG8_WAIT_V(4); PG8_BAR;
        PG8_STAGE(PG8_SB(1, 0), cB + kstep, voffB); PG8_STAGE(PG8_SA(1, 0), cA + kstep, voffA); PG8_STAGE(PG8_SB(1, 1), cB + hstep + kstep, voffB);
        PG8_WAIT_V(6); PG8_BAR;
    }
    for (;;) {
        const bool has_next = S.next(ui + 1, nxt);
        const char* nA = has_next ? (const char*)g.A + (size_t)nxt.pm * tstep : cA; const char* nB = has_next ? (const char*)g.Bt + (size_t)nxt.pn * tstep : cB;
        for (int t = 0; t < nt; t += 2) {
            const bool last = (t == nt - 2);
            const char* a1 = cA + (size_t)(t + 1) * kstep;
            const char* a2 = last ? nA : cA + (size_t)(t + 2) * kstep; const char* b2 = last ? nB : cB + (size_t)(t + 2) * kstep;
            const char* a3 = a2 + kstep; const char* b3 = b2 + kstep;
            if (last && has_next) S.a_ready(nxt);
            if constexpr (SP2) {
            PG8_LDB(B0, 0, 0); PG8_LDB(B1, 0, 1); PG8_SCHED; PG8_LDA(At, 0, 0); PG8_STAGE(PG8_SA(1, 1), a1 + hstep, voffA);
            PG8_WAIT_V(8); PG8_WAIT_L(0); PG8_BAR; PG8_MMA(0, 0, At, B0); PG8_MMA(0, 1, At, B1); PG8_BAR; PG8_SCHED;
            PG8_LDA(At, 0, 1); PG8_STAGE(PG8_SB(0, 0), b2, voffB); PG8_STAGE(PG8_SB(0, 1), b2 + hstep, voffB); PG8_STAGE(PG8_SA(0, 0), a2, voffA);
            PG8_WAIT_V(8); PG8_WAIT_L(0); PG8_BAR; PG8_MMA(1, 0, At, B0); PG8_MMA(1, 1, At, B1); PG8_BAR; PG8_SCHED;
            PG8_LDB(B0, 1, 0); PG8_LDB(B1, 1, 1); PG8_SCHED; PG8_LDA(At, 1, 0); PG8_STAGE(PG8_SA(0, 1), a2 + hstep, voffA);
            PG8_WAIT_V(8); PG8_WAIT_L(0); PG8_BAR; PG8_MMA(0, 0, At, B0); PG8_MMA(0, 1, At, B1); PG8_BAR; PG8_SCHED;
            PG8_LDA(At, 1, 1); PG8_STAGE(PG8_SB(1, 0), b3, voffB); PG8_STAGE(PG8_SB(1, 1), b3 + hstep, voffB); PG8_STAGE(PG8_SA(1, 0), a3, voffA);
            PG8_WAIT_V(8); PG8_WAIT_L(0); PG8_BAR; PG8_MMA(1, 0, At, B0); PG8_MMA(1, 1, At, B1); PG8_BAR; PG8_SCHED;
            } else {
            PG8_LDB(B0, 0, 0); PG8_SCHED; PG8_LDA(At, 0, 0); PG8_STAGE(PG8_SA(1, 1), a1 + hstep, voffA);
            PG8_WAIT_L(8); PG8_BAR; PG8_WAIT_L(0); PG8_MMA(0, 0, At, B0); PG8_BAR; PG8_SCHED;
            PG8_LDB(B1, 0, 1); PG8_STAGE(PG8_SB(0, 0), b2, voffB);
            PG8_BAR; PG8_WAIT_L(0); PG8_MMA(0, 1, At, B1); PG8_BAR;
            PG8_LDA(At, 0, 1); PG8_STAGE(PG8_SA(0, 0), a2, voffA);
            PG8_BAR; PG8_WAIT_L(0); PG8_MMA(1, 0, At, B0); PG8_BAR; PG8_SCHED;
            PG8_STAGE(PG8_SB(0, 1), b2 + hstep, voffB);
            PG8_WAIT_V(6); PG8_BAR; PG8_MMA(1, 1, At, B1); PG8_BAR;
            PG8_LDB(B0, 1, 0); PG8_SCHED; PG8_LDA(At, 1, 0); PG8_STAGE(PG8_SA(0, 1), a2 + hstep, voffA);
            PG8_WAIT_L(8); PG8_BAR; PG8_WAIT_L(0); PG8_MMA(0, 0, At, B0); PG8_BAR; PG8_SCHED;
            PG8_LDB(B1, 1, 1); PG8_STAGE(PG8_SB(1, 0), b3, voffB);
            PG8_BAR; PG8_WAIT_L(0); PG8_MMA(0, 1, At, B1); PG8_BAR;
            PG8_LDA(At, 1, 1); PG8_STAGE(PG8_SA(1, 0), a3, voffA);
            PG8_BAR; PG8_WAIT_L(0); PG8_MMA(1, 0, At, B0); PG8_BAR; PG8_SCHED;
            PG8_STAGE(PG8_SB(1, 1), b3 + hstep, voffB);
            PG8_WAIT_V(6); PG8_BAR; PG8_MMA(1, 1, At, B1); PG8_BAR;
            }
        }
        if constexpr (ALIGN_EPI) { if (wr == 0) PG8_BAR; }
        if constexpr (!Epi::AFTER_DRAIN) { E(acc, cur, wr, wc, fr, fq); S.done(cur); }
        if (!has_next) break;
#pragma unroll
        for (int a = 0; a < 2; ++a)
#pragma unroll
            for (int b = 0; b < 2; ++b)
#pragma unroll
                for (int m = 0; m < 4; ++m)
#pragma unroll
                    for (int n = 0; n < 2; ++n) acc[a][b][m][n] = (f32x4){0.f, 0.f, 0.f, 0.f};
        cur = nxt; cA = nA; cB = nB; ++ui;
        if constexpr (ALIGN_EPI) { if (wr == 1) PG8_BAR; }
    }
    PG8_WAIT_V(0);
    if constexpr (!ALIGN_EPI) { if (wr == 0) PG8_BAR; }
    PG8_BAR;
    if constexpr (Epi::AFTER_DRAIN) { E.fused(acc, cur, wr, wc, fr, fq, lds, wid, lane); S.done(cur); }
#undef PG8_SA
#undef PG8_SB
#undef PG8_STAGE
#undef PG8_LDA
#undef PG8_LDB
#undef PG8_MMA
#undef PG8_WAIT_V
#undef PG8_WAIT_L
#undef PG8_BAR
#undef PG8_SCHED
}
}

#define LAS __attribute__((address_space(3)))
typedef unsigned short bf16_t;
typedef float f32x4 __attribute__((ext_vector_type(4)));
typedef unsigned u32x4 __attribute__((ext_vector_type(4)));
typedef unsigned u32x2 __attribute__((ext_vector_type(2)));
typedef short bf16x8 __attribute__((ext_vector_type(8)));
typedef short bf16x4 __attribute__((ext_vector_type(4)));

constexpr int NTOK = 65536, DM = 2048, NPROMPT = 32768, DFF = 8192;
constexpr int PX = DM + 64, PH = DFF + 64;
constexpr float EPS = 1e-5f;
constexpr size_t MiB = 1u << 20;
constexpr size_t WS_RSTDX = 0, WS_SSH = 256 * 1024, WS_SSF = 512 * 1024, WS_TW = 768 * 1024;
constexpr size_t WS_H3A = 1 * MiB, WS_H3B = 2 * MiB;
constexpr size_t WS_WIN = 4 * MiB, WS_WOUT = 29 * MiB, WS_WUP = 38 * MiB, WS_WDN = 71 * MiB, WS_KH = 104 * MiB, WS_UT = 168 * MiB, WS_QKV = 552 * MiB, WS_ZA = 936 * MiB, WS_BAR = 968 * MiB, WS_END = 969 * MiB;
constexpr size_t WS_MIX = WS_UT, WS_HB = 620 * MiB, WS_HID = 104 * MiB;
constexpr size_t DO_XB = 0, DO_YT = 256 * MiB, DO_YNAT = 384 * MiB;
constexpr int LDS_BYTES = 147456;
constexpr int FFN_CHUNK = 32768, N_CHUNK = NTOK / FFN_CHUNK;
constexpr int N_PHASES = 5 + 2 * N_CHUNK + 1;

struct Params { const float* in[23]; float* out; unsigned char* ws; int ph_lo, ph_hi; };

__device__ __forceinline__ float wave_sum(float v) {
#pragma unroll
    for (int o = 1; o < 64; o <<= 1) v += __shfl_xor(v, o);
    return v;
}
__device__ __forceinline__ unsigned pk2(float lo, float hi) { return pg8::cvt_pk_bf16(lo, hi); }
__device__ __forceinline__ float bf2f(unsigned short b) { return __uint_as_float(((unsigned)b) << 16); }
__device__ __forceinline__ float bflo(unsigned w) { return __uint_as_float(w << 16); }
__device__ __forceinline__ float bfhi(unsigned w) { return __uint_as_float(w & 0xffff0000u); }

struct EpiUT {
    static constexpr bool PERM = true, AFTER_DRAIN = false;
    bf16_t* O; const float* rstd;
    __device__ __forceinline__ void operator()(const f32x4 (&acc)[2][2][4][2], const pg8::Unit& u, int wr, int wc, int fr, int fq) const {
        const int row0 = u.pm * 256 + wr * 64 + fr, col0 = u.pn * 256 + wc * 32 + 8 * fq;
#pragma unroll
        for (int ai = 0; ai < 2; ++ai)
#pragma unroll
            for (int m = 0; m < 4; ++m) { bf16_t* rowp = O + (size_t)(row0 + ai * 128 + m * 16) * NTOK + col0;
#pragma unroll
                for (int bj = 0; bj < 2; ++bj) { const f32x4 v0 = acc[ai][bj][m][0], v1 = acc[ai][bj][m][1];
                    u32x4 w; w.x = pk2(v0[0], v0[1]); w.y = pk2(v0[2], v0[3]); w.z = pk2(v1[0], v1[1]); w.w = pk2(v1[2], v1[3]);
                    *(u32x4*)(rowp + bj * 128) = w; } }
    }
};
struct EpiQKV {
    static constexpr bool PERM = true, AFTER_DRAIN = false;
    bf16_t* O; const float* rstd;
    __device__ __forceinline__ void operator()(const f32x4 (&acc)[2][2][4][2], const pg8::Unit& u, int wr, int wc, int fr, int fq) const {
        const int row0 = u.pm * 256 + wr * 64 + fr, col0 = u.pn * 256 + wc * 32 + 8 * fq;
#pragma unroll
        for (int ai = 0; ai < 2; ++ai)
#pragma unroll
            for (int m = 0; m < 4; ++m) { const int row = row0 + ai * 128 + m * 16; bf16_t* rowp = O + (size_t)row * 3072 + col0;
#pragma unroll
                for (int bj = 0; bj < 2; ++bj) { const f32x4 v0 = acc[ai][bj][m][0], v1 = acc[ai][bj][m][1];
                    u32x4 w; w.x = pk2(v0[0], v0[1]); w.y = pk2(v0[2], v0[3]); w.z = pk2(v1[0], v1[1]); w.w = pk2(v1[2], v1[3]);
                    *(u32x4*)(rowp + bj * 128) = w; } }
    }
};
struct EpiH {
    static constexpr bool PERM = true, AFTER_DRAIN = false;
    const float* xp; const float* xs; float* H; bf16_t* HB; float* ss;
    __device__ __forceinline__ void operator()(const f32x4 (&acc)[2][2][4][2], const pg8::Unit& u, int wr, int wc, int fr, int fq) const {
        const int row0 = u.pm * 256 + wr * 64 + fr, col0 = u.pn * 256 + wc * 32 + 8 * fq;
#pragma unroll
        for (int ai = 0; ai < 2; ++ai) {
            f32x4 xv[4][2][2];
#pragma unroll
            for (int m = 0; m < 4; ++m) { const int row = row0 + ai * 128 + m * 16;
                const float* xr = (row < NPROMPT ? xp + (size_t)row * DM : xs + (size_t)(row - NPROMPT) * DM) + col0;
#pragma unroll
                for (int bj = 0; bj < 2; ++bj) { xv[m][bj][0] = *(const f32x4*)(xr + bj * 128); xv[m][bj][1] = *(const f32x4*)(xr + bj * 128 + 4); } }
#pragma unroll
            for (int m = 0; m < 4; ++m) { const int row = row0 + ai * 128 + m * 16; bf16_t* br = HB + (size_t)row * PX + col0; float q = 0.f;
#pragma unroll
                for (int bj = 0; bj < 2; ++bj) { const f32x4 v0 = acc[ai][bj][m][0] + xv[m][bj][0], v1 = acc[ai][bj][m][1] + xv[m][bj][1];
                    u32x4 w; w.x = pk2(v0[0], v0[1]); w.y = pk2(v0[2], v0[3]); w.z = pk2(v1[0], v1[1]); w.w = pk2(v1[2], v1[3]);
                    *(u32x4*)(br + bj * 128) = w;
                    q += (v0[0] * v0[0] + v0[1] * v0[1]) + (v0[2] * v0[2] + v0[3] * v0[3]) + (v1[0] * v1[0] + v1[1] * v1[1]) + (v1[2] * v1[2] + v1[3] * v1[3]); }
                q += __shfl_xor(q, 16); q += __shfl_xor(q, 32);
                if (fq == 0) atomicAdd(ss + row, q); }
            asm volatile("" ::: "memory");
        }
    }
};
struct EpiUp {
    static constexpr bool PERM = true, AFTER_DRAIN = false;
    bf16_t* O; const float* ss;
    __device__ __forceinline__ void operator()(const f32x4 (&acc)[2][2][4][2], const pg8::Unit& u, int wr, int wc, int fr, int fq) const {
        const int row0 = u.pm * 256 + wr * 64 + fr, col0 = u.pn * 256 + wc * 32 + 8 * fq;
#pragma unroll
        for (int ai = 0; ai < 2; ++ai)
#pragma unroll
            for (int m = 0; m < 4; ++m) { const int row = row0 + ai * 128 + m * 16; bf16_t* rowp = O + (size_t)row * PH + col0;
#pragma unroll
                for (int bj = 0; bj < 2; ++bj) { f32x4 v0 = acc[ai][bj][m][0], v1 = acc[ai][bj][m][1];
#pragma unroll
                    for (int e = 0; e < 4; ++e) { const float a = fmaxf(v0[e], 0.f), b = fmaxf(v1[e], 0.f); v0[e] = a * a; v1[e] = b * b; }
                    u32x4 w; w.x = pk2(v0[0], v0[1]); w.y = pk2(v0[2], v0[3]); w.z = pk2(v1[0], v1[1]); w.w = pk2(v1[2], v1[3]);
                    *(u32x4*)(rowp + bj * 128) = w; } }
    }
};
struct EpiDown {
    static constexpr bool PERM = true, AFTER_DRAIN = false;
    bf16_t* HB; float* ss; const float* ssh;
    __device__ __forceinline__ void operator()(const f32x4 (&acc)[2][2][4][2], const pg8::Unit& u, int wr, int wc, int fr, int fq) const {
        const int row0 = u.pm * 256 + wr * 64 + fr, col0 = u.pn * 256 + wc * 32 + 8 * fq;
        u32x4 hw[2][4][2]; float s2[2][4];
#pragma unroll
        for (int ai = 0; ai < 2; ++ai)
#pragma unroll
            for (int m = 0; m < 4; ++m) { const int row = row0 + ai * 128 + m * 16; const bf16_t* br = HB + (size_t)row * PX + col0;
                hw[ai][m][0] = *(const u32x4*)br; hw[ai][m][1] = *(const u32x4*)(br + 128); s2[ai][m] = ssh[row]; }
#pragma unroll
        for (int ai = 0; ai < 2; ++ai)
#pragma unroll
            for (int m = 0; m < 4; ++m) { const int row = row0 + ai * 128 + m * 16; bf16_t* br = HB + (size_t)row * PX + col0; float q = 0.f; const float sc = 1.0f / (s2[ai][m] * (1.0f / DM) + EPS);
#pragma unroll
                for (int bj = 0; bj < 2; ++bj) { const u32x4 h = hw[ai][m][bj];
                    const f32x4 x0 = {bflo(h.x), bfhi(h.x), bflo(h.y), bfhi(h.y)}, x1 = {bflo(h.z), bfhi(h.z), bflo(h.w), bfhi(h.w)};
                    const f32x4 v0 = acc[ai][bj][m][0] * sc + x0, v1 = acc[ai][bj][m][1] * sc + x1;
                    u32x4 w; w.x = pk2(v0[0], v0[1]); w.y = pk2(v0[2], v0[3]); w.z = pk2(v1[0], v1[1]); w.w = pk2(v1[2], v1[3]);
                    *(u32x4*)(br + bj * 128) = w;
                    q += (v0[0] * v0[0] + v0[1] * v0[1]) + (v0[2] * v0[2] + v0[3] * v0[3]) + (v1[0] * v1[0] + v1[1] * v1[1]) + (v1[2] * v1[2] + v1[3] * v1[3]); }
                q += __shfl_xor(q, 16); q += __shfl_xor(q, 32);
                if (fq == 0) atomicAdd(ss + row, q); }
    }
};

__device__ __forceinline__ void transpose_item(const float* W, const float* g, int K, int N, bf16_t* WT, float* scr, int item, int lane) {
    const int nblk = N / 32, kb = item / nblk, nb = item % nblk, k0 = 64 * kb, n0 = 32 * nb;
#pragma unroll
    for (int i = 0; i < 8; ++i) { const int kk = 8 * i + (lane >> 3), nn = (lane & 7) * 4; const float sc = g ? g[k0 + kk] : 1.0f;
        const f32x4 w = *(const f32x4*)(W + (size_t)(k0 + kk) * N + n0 + nn) * sc; float* d = scr + kk * 33 + nn; d[0] = w[0]; d[1] = w[1]; d[2] = w[2]; d[3] = w[3]; }
    __builtin_amdgcn_s_waitcnt(0); __builtin_amdgcn_wave_barrier();
    const int c = lane & 7;
#pragma unroll
    for (int j = 0; j < 4; ++j) { const int n = (lane >> 3) + 8 * j; const float* s = scr + (8 * c) * 33 + n;
        u32x4 o; o.x = pk2(s[0 * 33], s[1 * 33]); o.y = pk2(s[2 * 33], s[3 * 33]); o.z = pk2(s[4 * 33], s[5 * 33]); o.w = pk2(s[6 * 33], s[7 * 33]);
        *(u32x4*)(WT + (size_t)(n0 + n) * (K + 64) + k0 + 8 * c) = o; }
    __builtin_amdgcn_s_waitcnt(0); __builtin_amdgcn_wave_barrier();
}

__device__ __forceinline__ void phase_prep(const Params& p, unsigned char* lds_raw) {
    unsigned char* ws = p.ws;
    const int tid = threadIdx.x, lane = tid & 63, wave = tid >> 6;
    const int gw = blockIdx.x * 8 + wave, NGW = gridDim.x * 8;
    const int gt = blockIdx.x * 512 + tid, NGT = gridDim.x * 512;
    { float* z1 = (float*)(ws + WS_SSH); float* z2 = (float*)(ws + WS_SSF);
      for (int i = gt; i < NTOK; i += NGT) { z1[i] = 0.f; z2[i] = 0.f; } }
    { float2* T = (float2*)(ws + WS_TW);
      for (int j = gt; j < 8192; j += NGT) { float s, c; sincospif((float)j * (1.0f / 8192.0f), &s, &c); T[j] = make_float2(c, -s); } }
    { bf16_t* xb = (bf16_t*)((unsigned char*)p.out + DO_XB); float* rstd = (float*)(ws + WS_RSTDX);
      for (int row = gw; row < NTOK; row += 2 * NGW) {
          const int r1 = row + NGW < NTOK ? row + NGW : row;
          const float* xr0 = row < NPROMPT ? p.in[0] + (size_t)row * DM : p.in[1] + (size_t)(row - NPROMPT) * DM;
          const float* xr1 = r1 < NPROMPT ? p.in[0] + (size_t)r1 * DM : p.in[1] + (size_t)(r1 - NPROMPT) * DM;
          f32x4 v0[8], v1[8]; float s0 = 0.f, s1 = 0.f;
#pragma unroll
          for (int j = 0; j < 8; ++j) { v0[j] = ((const f32x4*)xr0)[lane + 64 * j]; v1[j] = ((const f32x4*)xr1)[lane + 64 * j]; }
#pragma unroll
          for (int j = 0; j < 8; ++j) { s0 += (v0[j][0] * v0[j][0] + v0[j][1] * v0[j][1]) + (v0[j][2] * v0[j][2] + v0[j][3] * v0[j][3]); s1 += (v1[j][0] * v1[j][0] + v1[j][1] * v1[j][1]) + (v1[j][2] * v1[j][2] + v1[j][3] * v1[j][3]); }
          s0 = wave_sum(s0); s1 = wave_sum(s1);
          const float rs0 = 1.0f / sqrtf(s0 * (1.0f / DM) + EPS), rs1 = 1.0f / sqrtf(s1 * (1.0f / DM) + EPS);
          if (lane == 0) { rstd[row] = rs0; rstd[r1] = rs1; }
          u32x2* o0 = (u32x2*)(xb + (size_t)row * PX); u32x2* o1 = (u32x2*)(xb + (size_t)r1 * PX);
#pragma unroll
          for (int j = 0; j < 8; ++j) { u32x2 w; w.x = pk2(v0[j][0] * rs0, v0[j][1] * rs0); w.y = pk2(v0[j][2] * rs0, v0[j][3] * rs0); o0[lane + 64 * j] = w;
              u32x2 u; u.x = pk2(v1[j][0] * rs1, v1[j][1] * rs1); u.y = pk2(v1[j][2] * rs1, v1[j][3] * rs1); o1[lane + 64 * j] = u; }
      } }
    { float* scr = (float*)(lds_raw + wave * 16384);
      constexpr int I_IN = (DM / 64) * (6144 / 32), I_OUT = (DM / 64) * (DM / 32), I_UP = (DM / 64) * (DFF / 32), I_DN = (DFF / 64) * (DM / 32);
      for (int it = gw; it < I_IN + I_OUT + I_UP + I_DN; it += NGW) {
          int r = it;
          if (r < I_IN) { transpose_item(p.in[3], p.in[2], DM, 6144, (bf16_t*)(ws + WS_WIN), scr, r, lane); continue; } r -= I_IN;
          if (r < I_OUT) { transpose_item(p.in[18], nullptr, DM, DM, (bf16_t*)(ws + WS_WOUT), scr, r, lane); continue; } r -= I_OUT;
          if (r < I_UP) { transpose_item(p.in[20], p.in[19], DM, DFF, (bf16_t*)(ws + WS_WUP), scr, r, lane); continue; } r -= I_UP;
          transpose_item(p.in[21], nullptr, DFF, DM, (bf16_t*)(ws + WS_WDN), scr, r, lane);
      } }
    { const float* w1 = p.in[6]; const float* b1 = p.in[7]; const float* w2 = p.in[8]; const float* b2 = p.in[9]; const float* w3 = p.in[10]; const float* b3 = p.in[11]; const float* fr = p.in[12];
      const float frl = fr[lane];
      for (int it = gw; it < 4096 + 8192; it += NGW) {
          int L, t; bf16_t* h3;
          if (it < 4096) { L = 4096; t = it; h3 = (bf16_t*)(ws + WS_H3A); } else { L = 8192; t = it - 4096; h3 = (bf16_t*)(ws + WS_H3B); }
          const float tl = (float)t / (float)(L - 1);
          const float tpl = 2.0f * (float)t / (float)L;
          float a = tl * w1[lane];
#pragma unroll 4
          for (int b = 0; b < 16; ++b) { const float f = 1e-4f + (float)b * ((15.0f - 1e-4f) / 15.0f); float sn, cn; sincospif(tpl * f, &sn, &cn);
              a += cn * w1[(1 + b) * 64 + lane]; a -= sn * w1[(17 + b) * 64 + lane]; }
          float h = sinf(frl * (a + b1[lane]));
          a = 0.f;
#pragma unroll 8
          for (int i = 0; i < 64; ++i) a += __shfl(h, i) * w2[i * 64 + lane];
          h = sinf(frl * (a + b2[lane]));
          a = 0.f;
#pragma unroll 8
          for (int i = 0; i < 64; ++i) a += __shfl(h, i) * w3[i * 64 + lane];
          h = sinf(frl * (a + b3[lane]));
          h3[(size_t)lane * L + t] = (bf16_t)(pk2(h, 0.f) & 0xffffu);
      } }
}

typedef float c32 __attribute__((ext_vector_type(2)));
constexpr int LDS_TW = 73728, LDS_W4C = 139264;
__device__ __forceinline__ int PD(int i) { return i ^ ((i >> 5) & 7) ^ (((i >> 6) & 3) << 3); }
__device__ __forceinline__ c32 mk(float x, float y) { return (c32){x, y}; }
__device__ __forceinline__ c32 cmul(c32 a, c32 w) { return __builtin_shufflevector(a, a, 0, 0) * w + __builtin_shufflevector(a, a, 1, 1) * (c32){-w.y, w.x}; }
__device__ __forceinline__ c32 cmulc(c32 a, c32 w) { return __builtin_shufflevector(a, a, 0, 0) * (c32){w.x, -w.y} + __builtin_shufflevector(a, a, 1, 1) * (c32){w.y, w.x}; }
__device__ __forceinline__ c32 mul_w8(c32 a, int k) {
    constexpr float r = 0.70710678118654752f;
    return k == 0 ? a : k == 1 ? mk((a.x + a.y) * r, (a.y - a.x) * r) : k == 2 ? mk(a.y, -a.x) : mk((a.y - a.x) * r, -(a.x + a.y) * r);
}
__device__ __forceinline__ c32 mul_w8c(c32 a, int k) {
    constexpr float r = 0.70710678118654752f;
    return k == 0 ? a : k == 1 ? mk((a.x - a.y) * r, (a.x + a.y) * r) : k == 2 ? mk(-a.y, a.x) : mk(-(a.x + a.y) * r, (a.x - a.y) * r);
}
template <int S_HI, int NST>
__device__ __forceinline__ void fwd_group(c32 (&e)[1 << NST], const c32* TW, int low) {
    constexpr int R = 1 << NST, S_LO = S_HI - NST + 1;
    if constexpr (NST == 3) {
        const c32 w0 = TW[(1 << S_HI) + low], w1 = TW[(1 << (S_HI - 1)) + low], w2 = TW[(1 << S_LO) + low];
#pragma unroll
        for (int k = 0; k < 4; ++k) { const c32 a = e[k], b = e[k + 4]; e[k] = a + b; e[k + 4] = mul_w8(cmul(a - b, w0), k); }
#pragma unroll
        for (int h = 0; h < 2; ++h)
#pragma unroll
            for (int k = 0; k < 2; ++k) { const c32 a = e[4 * h + k], b = e[4 * h + k + 2]; e[4 * h + k] = a + b; e[4 * h + k + 2] = mul_w8(cmul(a - b, w1), 2 * k); }
#pragma unroll
        for (int k = 0; k < 8; k += 2) { const c32 a = e[k], b = e[k + 1]; e[k] = a + b; e[k + 1] = cmul(a - b, w2); }
        return;
    }
#pragma unroll
    for (int t = 0; t < NST; ++t) {
        const int s = S_HI - t, kd = R >> (t + 1);
#pragma unroll
        for (int k = 0; k < R; ++k) if (!(k & kd)) {
            const c32 w = TW[(1 << s) + low + ((k & (kd - 1)) << S_LO)];
            const c32 a = e[k], b = e[k + kd];
            e[k] = a + b;
            e[k + kd] = cmul(a - b, w);
        }
    }
}
template <int S_HI, int NST>
__device__ __forceinline__ void inv_group(c32 (&e)[1 << NST], const c32* TW, int low) {
    constexpr int R = 1 << NST, S_LO = S_HI - NST + 1;
    if constexpr (NST == 3) {
        const c32 w0 = TW[(1 << S_HI) + low], w1 = TW[(1 << (S_HI - 1)) + low], w2 = TW[(1 << S_LO) + low];
#pragma unroll
        for (int k = 0; k < 8; k += 2) { const c32 a = e[k], b = cmulc(e[k + 1], w2); e[k] = a + b; e[k + 1] = a - b; }
#pragma unroll
        for (int h = 0; h < 2; ++h)
#pragma unroll
            for (int k = 0; k < 2; ++k) { const c32 a = e[4 * h + k], b = mul_w8c(cmulc(e[4 * h + k + 2], w1), 2 * k); e[4 * h + k] = a + b; e[4 * h + k + 2] = a - b; }
#pragma unroll
        for (int k = 0; k < 4; ++k) { const c32 a = e[k], b = mul_w8c(cmulc(e[k + 4], w0), k); e[k] = a + b; e[k + 4] = a - b; }
        return;
    }
#pragma unroll
    for (int t = 0; t < NST; ++t) {
        const int s = S_LO + t, kd = 1 << t;
#pragma unroll
        for (int k = 0; k < R; ++k) if (!(k & kd)) {
            const c32 w = TW[(1 << s) + low + ((k & (kd - 1)) << S_LO)];
            const c32 a = e[k], b = cmulc(e[k + kd], w);
            e[k] = a + b;
            e[k + kd] = a - b;
        }
    }
}
__device__ __forceinline__ void fwd8_const(c32 (&e)[8]) {
#pragma unroll
    for (int k = 0; k < 4; ++k) { const c32 a = e[k], b = e[k + 4]; e[k] = a + b; e[k + 4] = mul_w8(a - b, k); }
#pragma unroll
    for (int h = 0; h < 2; ++h)
#pragma unroll
        for (int k = 0; k < 2; ++k) { const c32 a = e[4 * h + k], b = e[4 * h + k + 2]; e[4 * h + k] = a + b; e[4 * h + k + 2] = mul_w8(a - b, 2 * k); }
#pragma unroll
    for (int k = 0; k < 8; k += 2) { const c32 a = e[k], b = e[k + 1]; e[k] = a + b; e[k + 1] = a - b; }
}
__device__ __forceinline__ void inv8_const(c32 (&e)[8]) {
#pragma unroll
    for (int k = 0; k < 8; k += 2) { const c32 a = e[k], b = e[k + 1]; e[k] = a + b; e[k + 1] = a - b; }
#pragma unroll
    for (int h = 0; h < 2; ++h)
#pragma unroll
        for (int k = 0; k < 2; ++k) { const c32 a = e[4 * h + k], b = mul_w8c(e[4 * h + k + 2], 2 * k); e[4 * h + k] = a + b; e[4 * h + k + 2] = a - b; }
#pragma unroll
    for (int k = 0; k < 4; ++k) { const c32 a = e[k], b = mul_w8c(e[k + 4], k); e[k] = a + b; e[k + 4] = a - b; }
}
template <int LOG, int S_HI, bool INV>
__device__ __forceinline__ void pass8(c32* D, const c32* TW, int tid) {
    asm volatile("" : "+v"(tid));
    constexpr int L = 1 << LOG, S_LO = S_HI - 2, NGT = L / 8 / 512;
#pragma unroll
    for (int gi = 0; gi < NGT; ++gi) {
        const int g = tid + 512 * gi, low = g & ((1 << S_LO) - 1), base = ((g >> S_LO) << (S_HI + 1)) | low;
        c32 e[8];
#pragma unroll
        for (int k = 0; k < 8; ++k) e[k] = D[PD(base + (k << S_LO))];
        if (INV) inv_group<S_HI, 3>(e, TW, low); else fwd_group<S_HI, 3>(e, TW, low);
#pragma unroll
        for (int k = 0; k < 8; ++k) D[PD(base + (k << S_LO))] = e[k];
    }
}
template <int LOG>
__device__ __forceinline__ void fusedK(c32* D, const c32* TW, const c32* K, int tid) {
    asm volatile("" : "+v"(tid));
    constexpr int L = 1 << LOG, NGT = L / 8 / 512;
#pragma unroll
    for (int gi = 0; gi < NGT; ++gi) {
        const int g = tid + 512 * gi, base = g * 8;
        const f32x4* kp = (const f32x4*)(K + base);
        f32x4 kk[4];
#pragma unroll
        for (int j = 0; j < 4; ++j) kk[j] = kp[j];
        c32 e[8];
#pragma unroll
        for (int k = 0; k < 8; ++k) e[k] = D[PD(base + k)];
        fwd8_const(e);
#pragma unroll
        for (int k = 0; k < 8; ++k) e[k] = cmul(e[k], mk(kk[k >> 1][(k & 1) * 2], kk[k >> 1][(k & 1) * 2 + 1]));
        inv8_const(e);
#pragma unroll
        for (int k = 0; k < 8; ++k) D[PD(base + k)] = e[k];
    }
}
template <int LOG>
__device__ __forceinline__ void filt_last(c32* D, const c32* TW, c32* K, float bo, int tid) {
    asm volatile("" : "+v"(tid));
    constexpr int L = 1 << LOG, NGT = L / 8 / 512;
#pragma unroll
    for (int gi = 0; gi < NGT; ++gi) {
        const int g = tid + 512 * gi, base = g * 8;
        c32 e[8];
#pragma unroll
        for (int k = 0; k < 8; ++k) e[k] = D[PD(base + k)];
        fwd8_const(e);
        f32x4* kp = (f32x4*)(K + base);
#pragma unroll
        for (int j = 0; j < 4; ++j) kp[j] = (f32x4){e[2 * j].x + bo, e[2 * j].y, e[2 * j + 1].x + bo, e[2 * j + 1].y};
    }
}
__device__ __forceinline__ void lds_barrier() { asm volatile("s_waitcnt lgkmcnt(0)\n\ts_barrier" ::: "memory"); }
template <int LOG>
__device__ __forceinline__ void fft_head(c32 (&e)[1 << (LOG - 9)], c32* D, const c32* TW, int tid) {
    asm volatile("" : "+v"(tid));
    constexpr int NE = 1 << (LOG - 9);
    fwd_group<LOG - 1, LOG - 9>(e, TW, tid);
#pragma unroll
    for (int k = 0; k < NE; ++k) D[PD(tid) + 512 * k] = e[k];
    lds_barrier();
    pass8<LOG, 8, false>(D, TW, tid);
    lds_barrier();
    pass8<LOG, 5, false>(D, TW, tid);
    lds_barrier();
}
template <int LOG>
__device__ __forceinline__ void fft_tail(c32 (&e)[1 << (LOG - 9)], c32* D, const c32* TW, int tid) {
    asm volatile("" : "+v"(tid));
    constexpr int NE = 1 << (LOG - 9);
    lds_barrier();
    pass8<LOG, 5, true>(D, TW, tid);
    lds_barrier();
    pass8<LOG, 8, true>(D, TW, tid);
    lds_barrier();
#pragma unroll
    for (int k = 0; k < NE; ++k) e[k] = D[PD(tid) + 512 * k];
    inv_group<LOG - 1, LOG - 9>(e, TW, tid);
}
__device__ __forceinline__ float sconv(const bf16_t* base, int n, int L, float w0, float w1, float w2, float b) {
    const float l = n > 0 ? bf2f(base[n - 1]) : 0.f, m = bf2f(base[n]), r = n < L - 1 ? bf2f(base[n + 1]) : 0.f;
    return w0 * l + w1 * m + w2 * r + b;
}
template <int LOG>
__device__ __forceinline__ void stage_load(const bf16_t* b0, u32x4 (&v)[(1 << LOG) / 2048], int tid) {
    constexpr int L = 1 << LOG, NCH = L / 2048;
#pragma unroll
    for (int i = 0; i < NCH; ++i) { const int q = tid + 512 * i, row = q >> (LOG - 3), ch = q & ((L >> 3) - 1); v[i] = *(const u32x4*)(b0 + (size_t)row * L + ch * 8); }
}
template <int LOG>
__device__ __forceinline__ void stage_store(const u32x4 (&v)[(1 << LOG) / 2048], bf16_t* S, int tid) {
    constexpr int L = 1 << LOG, NCH = L / 2048;
#pragma unroll
    for (int i = 0; i < NCH; ++i) { const int q = tid + 512 * i, row = q >> (LOG - 3), ch = q & ((L >> 3) - 1); *(u32x4*)(S + row * (L + 16) + 8 + ch * 8) = v[i]; }
    if (tid < 2) { S[tid * (L + 16) + 7] = 0; S[tid * (L + 16) + 8 + L] = 0; }
}
__device__ __forceinline__ float sconvS(const bf16_t* S, int n, float w0, float w1, float w2, float b) {
    return w0 * bf2f(S[n - 1]) + w1 * bf2f(S[n]) + w2 * bf2f(S[n + 1]) + b;
}
template <int LOG>
__device__ __forceinline__ void hyena_item(const Params& p, int c, unsigned char* lds_raw, bool fill_tw) {
    constexpr int L = 1 << LOG, NE = L / 512, MS = 13 - LOG;
    constexpr int NB = (LOG == 13) ? 4 : 8, TOK0 = (LOG == 13) ? NPROMPT : 0;
    unsigned char* ws = p.ws;
    c32* D = (c32*)lds_raw; c32* TW = (c32*)(lds_raw + LDS_TW);
    const c32* T = (const c32*)(ws + WS_TW);
    const bf16_t* h3 = (const bf16_t*)(ws + (LOG == 13 ? WS_H3B : WS_H3A));
    c32* Kb = (c32*)(ws + WS_KH + (size_t)blockIdx.x * 262144);
    c32* Zg = (c32*)(ws + WS_ZA + (size_t)blockIdx.x * 131072); c32* Ag = Zg + L;
    const bf16_t* uT = (const bf16_t*)(ws + WS_UT);
    bf16_t* yT = (bf16_t*)((unsigned char*)p.out + DO_YT);
    const float* convw = p.in[4]; const float* convb = p.in[5]; const float* w4 = p.in[13]; const float* hbias = p.in[14];
    int tid = threadIdx.x;
    if (fill_tw) { for (int idx = tid; idx < L; idx += 512) { const int s = 31 - __clz(idx | 1), pos = idx - (1 << s); TW[idx] = T[pos << (13 - s)]; } }
    float* W4C = (float*)(lds_raw + LDS_W4C);
    if (tid < 256) W4C[tid] = w4[(size_t)(tid >> 2) * 4096 + (tid & 3) * 1024 + c];
    __syncthreads();
    const float adel = 3.0701134573253945f + (float)c * (12.280453829301578f / 1023.0f);
    { float* HF = (float*)D; float* HBk = HF + L; float* S1 = (float*)Zg;
#pragma unroll 1
      for (int ch = 0; ch < L / 4096; ++ch) {
          const int n0 = 8 * tid + 4096 * ch;
          f32x4 a[4][2];
#pragma unroll
          for (int q = 0; q < 4; ++q) { a[q][0] = (f32x4){0.f, 0.f, 0.f, 0.f}; a[q][1] = (f32x4){0.f, 0.f, 0.f, 0.f}; }
          const bf16_t* hr = h3 + n0;
#pragma unroll 8
          for (int j = 0; j < 64; ++j) {
              const f32x4 wv = *(const f32x4*)(W4C + 4 * j); const u32x4 hb = *(const u32x4*)(hr + (size_t)j * L);
              const f32x4 h0 = {bflo(hb.x), bfhi(hb.x), bflo(hb.y), bfhi(hb.y)}, h1 = {bflo(hb.z), bfhi(hb.z), bflo(hb.w), bfhi(hb.w)};
#pragma unroll
              for (int q = 0; q < 4; ++q) { a[q][0] += h0 * wv[q]; a[q][1] += h1 * wv[q]; }
          }
#pragma unroll
          for (int h = 0; h < 2; ++h) { f32x4 dec;
#pragma unroll
              for (int e = 0; e < 4; ++e) dec[e] = expf(-((float)(n0 + 4 * h + e) / (float)(L - 1)) * adel);
              *(f32x4*)(HF + n0 + 4 * h) = a[0][h] * dec; *(f32x4*)(HBk + n0 + 4 * h) = a[1][h] * dec;
              *(f32x4*)(S1 + n0 + 4 * h) = a[2][h] * dec; *(f32x4*)(S1 + L + n0 + 4 * h) = a[3][h] * dec; }
      } }
#pragma unroll 1
    for (int o = 0; o < 2; ++o) {
        asm volatile("" : "+v"(tid));
        float* HF = (float*)D; float* HBk = HF + L;
        if (o == 1) {
#pragma unroll 2
            for (int i = 0; i < NE; ++i) { const int n = tid + 512 * i; HF[n] = ((const float*)Zg)[n]; HBk[n] = ((const float*)Zg)[L + n]; }
        }
        __syncthreads();
        float hfv[NE], hbv[NE];
#pragma unroll
        for (int k = 0; k < NE; ++k) { const int n = tid + 512 * k; hfv[k] = HF[n]; hbv[k] = n ? HBk[L - n] : 0.f; }
        __syncthreads();
        const float bo = hbias[o * 1024 + c];
        asm volatile("" : "+v"(tid));
        { c32 e[NE];
#pragma unroll
          for (int k = 0; k < NE; ++k) e[k] = mk(hfv[k] + hbv[k], 0.f);
          fft_head<LOG>(e, D, TW, tid);
          filt_last<LOG>(D, TW, Kb + (size_t)(o * 2 + 0) * L, bo, tid);
          __syncthreads();
          asm volatile("" : "+v"(tid));
          const c32 wt = T[tid << MS];
#pragma unroll
          for (int k = 0; k < NE; ++k) { const c32 w = cmul(wt, T[(512 * k) << MS]); const float d = hfv[k] - hbv[k]; e[k] = mk(d * w.x, d * w.y); }
          fft_head<LOG>(e, D, TW, tid);
          filt_last<LOG>(D, TW, Kb + (size_t)(o * 2 + 1) * L, bo, tid);
          __syncthreads(); }
    }
    const float inv2L = 1.0f / (float)(2 * L);
    u32x4 pf[L / 2048];
    stage_load<LOG>(uT + (size_t)c * NTOK + TOK0, pf, tid);
#pragma unroll 1
    for (int pr = 0; pr < NB / 2; ++pr) {
        const size_t tbase = (size_t)TOK0 + (size_t)(2 * pr) * L;
        c32 z[NE];
        { bf16_t* S = (bf16_t*)lds_raw;
          const float w0 = convw[c], w1 = convw[3072 + c], w2 = convw[6144 + c], bb = convb[c];
          stage_store<LOG>(pf, S, tid);
          __syncthreads();
#pragma unroll
          for (int k = 0; k < NE; ++k) { const int n = tid + 512 * k; z[k] = mk(sconvS(S + 8, n, w0, w1, w2, bb), sconvS(S + (L + 16) + 8, n, w0, w1, w2, bb)); } }
        __syncthreads();
#pragma unroll 1
        for (int o = 0; o < 2; ++o) {
            const c32* K0 = Kb + (size_t)(o * 2 + 0) * L; const c32* K1 = Kb + (size_t)(o * 2 + 1) * L;
            c32 e[NE], a[NE];
            asm volatile("" : "+v"(tid));
            const c32 wt = T[tid << MS];
#pragma unroll
            for (int k = 0; k < NE; ++k) e[k] = z[k];
            fft_head<LOG>(e, D, TW, tid);
            fusedK<LOG>(D, TW, K0, tid);
            fft_tail<LOG>(e, D, TW, tid);
#pragma unroll
            for (int k = 0; k < NE; ++k) a[k] = e[k];
            asm volatile("" : "+v"(tid));
            stage_load<LOG>(uT + (size_t)((o + 1) * 1024 + c) * NTOK + tbase, pf, tid);
#pragma unroll
            for (int k = 0; k < NE; ++k) e[k] = cmul(z[k], cmul(wt, T[(512 * k) << MS]));
            fft_head<LOG>(e, D, TW, tid);
            fusedK<LOG>(D, TW, K1, tid);
            fft_tail<LOG>(e, D, TW, tid);
            asm volatile("" : "+v"(tid));
            __syncthreads();
            { const int gc = (o + 1) * 1024 + c; bf16_t* S = (bf16_t*)lds_raw; bf16_t* Ys = (bf16_t*)(lds_raw + 36864);
              stage_store<LOG>(pf, S, tid);
              if (o == 1 && pr + 1 < NB / 2) stage_load<LOG>(uT + (size_t)c * NTOK + tbase + 2 * L, pf, tid);
              const float w0 = convw[gc], w1 = convw[3072 + gc], w2 = convw[6144 + gc], bb = convb[gc];
              __syncthreads();
#pragma unroll
              for (int k = 0; k < NE; ++k) { const int n = tid + 512 * k; const c32 d = cmulc(e[k], cmul(wt, T[(512 * k) << MS]));
                  z[k] = mk(sconvS(S + 8, n, w0, w1, w2, bb) * ((a[k].x + d.x) * inv2L), sconvS(S + (L + 16) + 8, n, w0, w1, w2, bb) * ((a[k].y + d.y) * inv2L));
                  if (o == 1) { Ys[n] = (bf16_t)(pk2(z[k].x, 0.f) & 0xffffu); Ys[L + n] = (bf16_t)(pk2(z[k].y, 0.f) & 0xffffu); } } }
            __syncthreads();
        }
        { bf16_t* y0 = yT + (size_t)c * NTOK + tbase; const bf16_t* Ys = (const bf16_t*)(lds_raw + 36864);
#pragma unroll
          for (int i = 0; i < L / 2048; ++i) { const int q = tid + 512 * i; *(u32x4*)(y0 + (size_t)q * 8) = *(const u32x4*)(Ys + q * 8); } }
        __syncthreads();
    }
}

template <int KR>
__device__ __forceinline__ void tr_read8(u32x2 (&v)[4][2], unsigned b0, unsigned b1, unsigned b2, unsigned b3) {
    asm volatile(
        "ds_read_b64_tr_b16 %0, %8 offset:%12\n\t"
        "ds_read_b64_tr_b16 %1, %8 offset:%13\n\t"
        "ds_read_b64_tr_b16 %2, %9 offset:%12\n\t"
        "ds_read_b64_tr_b16 %3, %9 offset:%13\n\t"
        "ds_read_b64_tr_b16 %4, %10 offset:%12\n\t"
        "ds_read_b64_tr_b16 %5, %10 offset:%13\n\t"
        "ds_read_b64_tr_b16 %6, %11 offset:%12\n\t"
        "ds_read_b64_tr_b16 %7, %11 offset:%13\n\t"
        "s_waitcnt lgkmcnt(0)"
        : "=&v"(v[0][0]), "=&v"(v[0][1]), "=&v"(v[1][0]), "=&v"(v[1][1]), "=&v"(v[2][0]), "=&v"(v[2][1]), "=&v"(v[3][0]), "=&v"(v[3][1])
        : "v"(b0), "v"(b1), "v"(b2), "v"(b3), "i"(KR * 8192), "i"(KR * 8192 + 2048)
        : "memory");
}
__device__ __forceinline__ void nat_item(const Params& p, int idx, unsigned char* lds_raw) {
    unsigned char* ws = p.ws;
    const bf16_t* qkv = (const bf16_t*)(ws + WS_QKV);
    bf16_t* ynat = (bf16_t*)((unsigned char*)p.out + DO_YNAT);
    const float* rpb = p.in[15];
    float* RP = (float*)(lds_raw + 122880);
    const int tid = threadIdx.x;
    int ib, head, rows, tok0;
    if (idx < 1024) { const int bg = idx >> 7, rem = idx & 127; ib = rem >> 4; head = rem & 15; rows = 64; tok0 = bg * 4096; }
    else { const int x = idx - 1024, bg = x >> 8, rem = x & 255; ib = rem >> 4; head = rem & 15; rows = 128; tok0 = NPROMPT + bg * 8192; }
    const int i0 = ib * 8, R0 = min(max(i0 - 4, 0), rows - 15);
#pragma unroll 5
    for (int it = 0; it < 15; ++it) {
        const int q = tid + 512 * it, tokl = q >> 3, ch = q & 7;
        const u32x4 v = *(const u32x4*)(qkv + (size_t)(tok0 + R0 * 64 + tokl) * 3072 + 2048 + head * 64 + ch * 8);
        *(u32x4*)(lds_raw + tokl * 128 + ((ch ^ (((tokl >> 1) & 3) << 1)) << 4)) = v;
    }
    if (tid < 465) RP[tid] = rpb[head * 465 + tid] * 1.4426950408889634f;
    __syncthreads();
    const int w = tid >> 6, lane = tid & 63, r = lane & 15, q = lane >> 4;
    const int jt = w & 3;
    const int sp = (jt == 0) ? 0 : (jt == 1) ? 8 : (jt == 2) ? 24 : 32;
    const int j = jt * 16 + r;
    const int cs = min(max(j - 8, 0), 48);
    unsigned vb0[4];
    { const int g = q, l16 = lane & 15, qq = l16 >> 2, pp = l16 & 3, key0 = sp + 4 * g + qq, swz = ((key0 >> 1) & 3) << 1;
      const unsigned lbase = (unsigned)(size_t)lds_raw + key0 * 128 + 8 * (pp & 1);
#pragma unroll
      for (int dt = 0; dt < 4; ++dt) vb0[dt] = lbase + ((((2 * dt + (pp >> 1)) ^ swz)) << 4); }
#pragma unroll 1
    for (int rnd = 0; rnd < 4; ++rnd) {
        const int i = i0 + (w >> 2) + 2 * rnd;
        const int rs = min(max(i - 4, 0), rows - 8);
        const size_t tq = (size_t)tok0 + (size_t)i * 64 + j;
        const bf16_t* qp = qkv + tq * 3072 + head * 64 + q * 8;
        const bf16x8 qf0 = *(const bf16x8*)qp, qf1 = *(const bf16x8*)(qp + 32);
        float sc[8][2][4];
        float sum = 0.f;
#pragma unroll
        for (int kr = 0; kr < 8; ++kr) {
            const float* bp = RP + (rs + kr - i + 7) * 31;
#pragma unroll
            for (int ct = 0; ct < 2; ++ct) {
                const bf16_t* kp = qkv + (size_t)(tok0 + (rs + kr) * 64 + sp + ct * 16 + r) * 3072 + 1024 + head * 64 + q * 8;
                const bf16x8 k0 = *(const bf16x8*)kp, k1 = *(const bf16x8*)(kp + 32);
                f32x4 s = {0.f, 0.f, 0.f, 0.f};
                s = __builtin_amdgcn_mfma_f32_16x16x32_bf16(k0, qf0, s, 0, 0, 0);
                s = __builtin_amdgcn_mfma_f32_16x16x32_bf16(k1, qf1, s, 0, 0, 0);
#pragma unroll
                for (int e = 0; e < 4; ++e) {
                    const int col = sp + ct * 16 + 4 * q + e; const bool valid = (col >= cs) && (col <= cs + 15);
                    const int co = min(max(col - j + 15, 0), 30);
                    const float pv = valid ? __builtin_amdgcn_exp2f(fminf(s[e] * (0.125f * 1.4426950408889634f) + bp[co], 80.0f)) : 0.f;
                    sc[kr][ct][e] = pv; sum += pv;
                }
            }
        }
        sum += __shfl_xor(sum, 16); sum += __shfl_xor(sum, 32);
        f32x4 acc[4];
#pragma unroll
        for (int dt = 0; dt < 4; ++dt) acc[dt] = (f32x4){0.f, 0.f, 0.f, 0.f};
        const unsigned roff = (unsigned)(rs - R0) * 8192u;
        const unsigned vb[4] = {vb0[0] + roff, vb0[1] + roff, vb0[2] + roff, vb0[3] + roff};
#define NAT_PV(KR) do { u32x2 vv[4][2]; tr_read8<KR>(vv, vb[0], vb[1], vb[2], vb[3]); \
        u32x4 pw; pw.x = pk2(sc[KR][0][0], sc[KR][0][1]); pw.y = pk2(sc[KR][0][2], sc[KR][0][3]); pw.z = pk2(sc[KR][1][0], sc[KR][1][1]); pw.w = pk2(sc[KR][1][2], sc[KR][1][3]); \
        const bf16x8 pb = __builtin_bit_cast(bf16x8, pw); \
        _Pragma("unroll") for (int dt = 0; dt < 4; ++dt) { u32x4 vw; vw.x = vv[dt][0].x; vw.y = vv[dt][0].y; vw.z = vv[dt][1].x; vw.w = vv[dt][1].y; \
            acc[dt] = __builtin_amdgcn_mfma_f32_16x16x32_bf16(__builtin_bit_cast(bf16x8, vw), pb, acc[dt], 0, 0, 0); } } while (0)
        NAT_PV(0); NAT_PV(1); NAT_PV(2); NAT_PV(3); NAT_PV(4); NAT_PV(5); NAT_PV(6); NAT_PV(7);
#undef NAT_PV
        const float inv = 1.0f / sum;
        bf16_t* op = ynat + tq * 1024 + head * 64 + 4 * q;
#pragma unroll
        for (int dt = 0; dt < 4; ++dt) { u32x2 o; o.x = pk2(acc[dt][0] * inv, acc[dt][1] * inv); o.y = pk2(acc[dt][2] * inv, acc[dt][3] * inv); *(u32x2*)(op + dt * 16) = o; }
    }
    __syncthreads();
}

__device__ __forceinline__ void norm_item(const Params& p, int item, unsigned char* lds_raw) {
    unsigned char* ws = p.ws;
    const bf16_t* yT = (const bf16_t*)((unsigned char*)p.out + DO_YT);
    const bf16_t* ynat = (const bf16_t*)((unsigned char*)p.out + DO_YNAT);
    bf16_t* mix = (bf16_t*)(ws + WS_MIX);
    const float* ghy = p.in[16]; const float* gnat = p.in[17];
    bf16_t* Tl = (bf16_t*)lds_raw;
    const int tid = threadIdx.x, lane = tid & 63, w = tid >> 6;
    const int tokb = item * 64;
    u32x4 na[8][2];
#pragma unroll
    for (int tt = 0; tt < 8; ++tt) { const u32x4* src = (const u32x4*)(ynat + ((size_t)tokb + w * 8 + tt) * 1024); na[tt][0] = src[lane]; na[tt][1] = src[lane + 64]; }
#pragma unroll 4
    for (int it = 0; it < 16; ++it) {
        const int q = tid + 512 * it, c = q >> 3, ch = q & 7;
        const u32x4 v = *(const u32x4*)(yT + (size_t)c * NTOK + tokb + ch * 8);
        unsigned* dst = (unsigned*)(Tl + c * 66 + ch * 8);
        dst[0] = v.x; dst[1] = v.y; dst[2] = v.z; dst[3] = v.w;
    }
    float gh[16];
#pragma unroll
    for (int jj = 0; jj < 8; ++jj) { gh[2 * jj] = ghy[2 * lane + 128 * jj]; gh[2 * jj + 1] = ghy[2 * lane + 128 * jj + 1]; }
    f32x4 gn[2][2];
#pragma unroll
    for (int h = 0; h < 2; ++h) { gn[h][0] = *(const f32x4*)(gnat + h * 512 + lane * 8); gn[h][1] = *(const f32x4*)(gnat + h * 512 + lane * 8 + 4); }
    __syncthreads();
#pragma unroll
    for (int tt = 0; tt < 8; ++tt) {
        const int tl = w * 8 + tt; const size_t tok = (size_t)tokb + tl;
        float v[16]; float ss = 0.f;
#pragma unroll
        for (int jj = 0; jj < 8; ++jj) { const int c = 2 * lane + 128 * jj; v[2 * jj] = bf2f(Tl[c * 66 + tl]); v[2 * jj + 1] = bf2f(Tl[(c + 1) * 66 + tl]); ss += v[2 * jj] * v[2 * jj] + v[2 * jj + 1] * v[2 * jj + 1]; }
        ss = wave_sum(ss);
        const float rstd = 1.0f / sqrtf(ss * (1.0f / 1024.0f) + EPS);
        bf16_t* mo = mix + tok * PX;
#pragma unroll
        for (int jj = 0; jj < 8; ++jj) *(unsigned*)(mo + 2 * lane + 128 * jj) = pk2(v[2 * jj] * rstd * gh[2 * jj], v[2 * jj + 1] * rstd * gh[2 * jj + 1]);
        float f[16]; float s2 = 0.f;
#pragma unroll
        for (int h = 0; h < 2; ++h) { const u32x4 a = na[tt][h]; f[h * 8 + 0] = bflo(a.x); f[h * 8 + 1] = bfhi(a.x); f[h * 8 + 2] = bflo(a.y); f[h * 8 + 3] = bfhi(a.y);
            f[h * 8 + 4] = bflo(a.z); f[h * 8 + 5] = bfhi(a.z); f[h * 8 + 6] = bflo(a.w); f[h * 8 + 7] = bfhi(a.w); }
#pragma unroll
        for (int e = 0; e < 16; ++e) s2 += f[e] * f[e];
        s2 = wave_sum(s2);
        const float r2 = 1.0f / sqrtf(s2 * (1.0f / 1024.0f) + EPS);
        u32x4* dst = (u32x4*)(mo + 1024);
#pragma unroll
        for (int h = 0; h < 2; ++h) { const f32x4 g0 = gn[h][0], g1 = gn[h][1];
            u32x4 o; o.x = pk2(f[h * 8 + 0] * r2 * g0[0], f[h * 8 + 1] * r2 * g0[1]); o.y = pk2(f[h * 8 + 2] * r2 * g0[2], f[h * 8 + 3] * r2 * g0[3]);
            o.z = pk2(f[h * 8 + 4] * r2 * g1[0], f[h * 8 + 5] * r2 * g1[1]); o.w = pk2(f[h * 8 + 6] * r2 * g1[2], f[h * 8 + 7] * r2 * g1[3]);
            dst[lane + 64 * h] = o; }
    }
    __syncthreads();
}

#define XB_TMO      128
#define XB_XCNT(j)  (256  + 64 * (j))
#define XB_XSUB(j)  (1280 + 64 * (j))
#define XB_XGEN(j)  (2304 + 64 * (j))
#define XB_TOP      3328
#define XB_TOPGEN   3392
#define XCD_BAR_WORDS 3456
#define XB_SPIN_CAP (1u << 18)

__device__ __forceinline__ unsigned xb_ld(unsigned* p)              { return __hip_atomic_load(p, __ATOMIC_RELAXED, __HIP_MEMORY_SCOPE_AGENT); }
__device__ __forceinline__ unsigned xb_add(unsigned* p, unsigned v) { return __hip_atomic_fetch_add(p, v, __ATOMIC_RELAXED, __HIP_MEMORY_SCOPE_AGENT); }
__device__ __forceinline__ unsigned xb_xcc_id() { return (unsigned)__builtin_amdgcn_s_getreg((3 << 11) | 20) & 0xFu; }
#define XB_SPIN(cond, bar) do { unsigned _sp = 0; while (cond) { __builtin_amdgcn_s_sleep(1); \
    if ((++_sp & 255u) == 0u) { if (xb_ld(&(bar)[XB_TMO])) break; if (_sp > XB_SPIN_CAP) { atomicAdd(&(bar)[XB_TMO], 1u); break; } } } } while (0)

struct XcdBarrier {
    unsigned* bar; unsigned x;
    volatile LAS unsigned* st;
};

__device__ __forceinline__ XcdBarrier xcd_barrier_post(unsigned* bar, volatile LAS unsigned* st) {
    XcdBarrier b; b.bar = bar; b.x = xb_xcc_id(); b.st = st;
    if (threadIdx.x == 0) (void)xb_add(&bar[XB_XCNT(b.x)], 1u);
    return b;
}
__device__ __forceinline__ void xcd_barrier_complete(unsigned* bar, unsigned x, unsigned& nloc, unsigned& nx) {
    const unsigned G = gridDim.x * gridDim.y * gridDim.z;
    unsigned sum, cnt, mine, sp = 0u;
    for (;;) {
        sum = 0u; cnt = 0u; mine = 0u;
#pragma unroll
        for (unsigned j = 0; j < 16; ++j) { const unsigned c = xb_ld(&bar[XB_XCNT(j)]); sum += c; cnt += (c > 0u) ? 1u : 0u; mine = (j == x) ? c : mine; }
        if (sum == G) break;
        __builtin_amdgcn_s_sleep(1);
        if ((++sp & 255u) == 0u) { if (xb_ld(&bar[XB_TMO])) break; if (sp > XB_SPIN_CAP) { atomicAdd(&bar[XB_TMO], 1u); break; } }
    }
    nloc = mine > 0u ? mine : 1u; nx = cnt > 0u ? cnt : 1u;
}

__device__ __forceinline__ void xcd_barrier(const XcdBarrier& b) {
    asm volatile("s_waitcnt vmcnt(0)" ::: "memory");
    __syncthreads();
    if (threadIdx.x == 0) {
        unsigned* bar = b.bar;
        __builtin_amdgcn_s_waitcnt(0);
        unsigned nloc = b.st[0], nx = b.st[1];
        if (nloc == 0u) { xcd_barrier_complete(bar, b.x, nloc, nx); b.st[0] = nloc; b.st[1] = nx; }
        const unsigned old = xb_add(&bar[XB_XSUB(b.x)], 1u);
        const unsigned gen = old / nloc;
        if (old + 1u == (gen + 1u) * nloc) {
            __builtin_amdgcn_fence(__ATOMIC_RELEASE, "agent");
            asm volatile("s_waitcnt vmcnt(0)" ::: "memory");
            const unsigned og = xb_add(&bar[XB_TOP], 1u);
            const unsigned tg = og / nx;
            if (og + 1u == (tg + 1u) * nx) xb_add(&bar[XB_TOPGEN], 1u);
            else XB_SPIN(xb_ld(&bar[XB_TOPGEN]) == tg, bar);
            __builtin_amdgcn_fence(__ATOMIC_ACQUIRE, "agent");
            xb_add(&bar[XB_XGEN(b.x)], 1u);
            asm volatile("s_waitcnt vmcnt(0)" ::: "memory");
        } else {
            XB_SPIN(xb_ld(&bar[XB_XGEN(b.x)]) == gen, bar);
            __builtin_amdgcn_fence(__ATOMIC_ACQUIRE, "agent");
            asm volatile("s_waitcnt vmcnt(0)" ::: "memory");
        }
    }
    __syncthreads();
}

__global__ void __launch_bounds__(512, 2) fwd_kernel(Params p) {
    extern __shared__ __attribute__((aligned(16))) unsigned char lds_raw[];
    cg::grid_group grid = cg::this_grid();
    LAS unsigned char* lds = (LAS unsigned char*)lds_raw;
    unsigned char* ws = p.ws;
    const int lo = p.ph_lo, hi = p.ph_hi;
    const int G = gridDim.x, bx = blockIdx.x;
#ifndef PHMASK
#define PHMASK 0xFFFFFF
#endif
#define IN(k) (((PHMASK >> (k)) & 1) && lo <= (k) && (k) < hi)
    volatile LAS unsigned* bst = (volatile LAS unsigned*)(lds + (LDS_BYTES - 64));
    if (threadIdx.x < 2) bst[threadIdx.x] = 0u;
    __syncthreads();
    XcdBarrier xbar = xcd_barrier_post((unsigned*)(ws + WS_BAR), bst);
#define SEAM(k) do { if ((k) + 1 < hi) { if ((k) == 0) grid.sync(); else xcd_barrier(xbar); } } while (0)
    bf16_t* xb = (bf16_t*)((unsigned char*)p.out + DO_XB);
    float* rstdx = (float*)(ws + WS_RSTDX); float* ssh = (float*)(ws + WS_SSH); float* ssf = (float*)(ws + WS_SSF);

    if (IN(0)) { phase_prep(p, lds_raw); SEAM(0); }
    if (IN(1)) {
        { pg8::Gemm g{(const bf16_t*)(ws + WS_WIN), xb, 3072, NTOK, DM}; pg8::StaticOrder S; S.init(3072, NTOK, G, bx);
          EpiUT E{(bf16_t*)(ws + WS_UT), rstdx};
          pg8::gemm_phase<EpiUT, pg8::StaticOrder, true, true>(lds, g, S, E); }
        { pg8::Gemm g{xb, (const bf16_t*)(ws + WS_WIN) + (size_t)3072 * PX, NTOK, 3072, DM}; pg8::StaticOrder S; S.init(NTOK, 3072, G, bx);
          EpiQKV E{(bf16_t*)(ws + WS_QKV), rstdx};
          pg8::gemm_phase<EpiQKV, pg8::StaticOrder, true, true>(lds, g, S, E); }
        SEAM(1);
    }
    if (IN(2)) {
#ifndef NO_NAT
        for (int it = bx; it < 2048; it += G) nat_item(p, it, lds_raw);
#endif
#ifndef NO_HY12
        for (int it = bx; it < 1024; it += G) hyena_item<12>(p, it, lds_raw, it == bx);
#endif
#ifndef NO_HY13
        for (int it = bx; it < 1024; it += G) hyena_item<13>(p, it, lds_raw, it == bx);
#endif
        SEAM(2);
    }
    if (IN(3)) { for (int it = bx; it < 1024; it += G) norm_item(p, it, lds_raw); SEAM(3); }
    if (IN(4)) {
        pg8::Gemm g{(const bf16_t*)(ws + WS_MIX), (const bf16_t*)(ws + WS_WOUT), NTOK, DM, DM}; pg8::StaticOrder S; S.init(NTOK, DM, G, bx);
        EpiH E{p.in[0], p.in[1], p.out, (bf16_t*)(ws + WS_HB), ssh};
        pg8::gemm_phase<EpiH, pg8::StaticOrder, true, true>(lds, g, S, E);
        SEAM(4);
    }
#pragma unroll 1
    for (int ck = 0; ck < N_CHUNK; ++ck) {
        if (IN(5 + 2 * ck)) {
            pg8::Gemm g{(const bf16_t*)(ws + WS_HB) + (size_t)ck * FFN_CHUNK * PX, (const bf16_t*)(ws + WS_WUP), FFN_CHUNK, DFF, DM}; pg8::StaticOrder S; S.init(FFN_CHUNK, DFF, G, bx);
            EpiUp E{(bf16_t*)(ws + WS_HID), ssh + ck * FFN_CHUNK};
            pg8::gemm_phase<EpiUp, pg8::StaticOrder, true, true>(lds, g, S, E);
            SEAM(5 + 2 * ck);
        }
        if (IN(6 + 2 * ck)) {
            pg8::Gemm g{(const bf16_t*)(ws + WS_HID), (const bf16_t*)(ws + WS_WDN), FFN_CHUNK, DM, DFF}; pg8::StaticOrder S; S.init(FFN_CHUNK, DM, G, bx);
            EpiDown E{(bf16_t*)(ws + WS_HB) + (size_t)ck * FFN_CHUNK * PX, ssf + ck * FFN_CHUNK, ssh + ck * FFN_CHUNK};
            pg8::gemm_phase<EpiDown, pg8::StaticOrder, true, true>(lds, g, S, E);
            SEAM(6 + 2 * ck);
        }
    }
    if (IN(N_PHASES - 1)) {
        const int tid = threadIdx.x, lane = tid & 63, gw = bx * 8 + (tid >> 6), NGW = G * 8;
        const f32x4* gf = (const f32x4*)p.in[22];
        const bf16_t* h2 = (const bf16_t*)(ws + WS_HB);
        f32x4 gg[4][2];
#pragma unroll
        for (int j = 0; j < 4; ++j) { gg[j][0] = gf[2 * (lane + 64 * j)]; gg[j][1] = gf[2 * (lane + 64 * j) + 1]; }
        for (int row = gw; row < NTOK; row += 4 * NGW) {
            u32x4 hw[4][4]; float rs[4];
#pragma unroll
            for (int r = 0; r < 4; ++r) { const int rr = row + r * NGW < NTOK ? row + r * NGW : row; const u32x4* hr = (const u32x4*)(h2 + (size_t)rr * PX);
#pragma unroll
                for (int j = 0; j < 4; ++j) hw[r][j] = hr[lane + 64 * j];
                rs[r] = 1.0f / sqrtf(ssf[rr] * (1.0f / DM) + EPS); }
#pragma unroll
            for (int r = 0; r < 4; ++r) { const int rr = row + r * NGW < NTOK ? row + r * NGW : row; f32x4* o = (f32x4*)(p.out + (size_t)rr * DM);
#pragma unroll
                for (int j = 0; j < 4; ++j) { const u32x4 h = hw[r][j];
                    const f32x4 x0 = {bflo(h.x), bfhi(h.x), bflo(h.y), bfhi(h.y)}, x1 = {bflo(h.z), bfhi(h.z), bflo(h.w), bfhi(h.w)};
                    o[2 * (lane + 64 * j)] = x0 * rs[r] * gg[j][0]; o[2 * (lane + 64 * j) + 1] = x1 * rs[r] * gg[j][1]; } }
        }
    }
#undef IN
#undef SEAM
}

extern "C" void kernel_launch(void* const* d_in, const int* in_sizes, int n_in, void* d_out, int out_size, void* d_ws, size_t ws_size, hipStream_t stream) {
    static int grid = 0;
    if (grid == 0) {
        int dev = 0, cus = 0, per_cu = 0;
        hipGetDevice(&dev);
        hipDeviceGetAttribute(&cus, hipDeviceAttributeMultiprocessorCount, dev);
        hipFuncSetAttribute((const void*)fwd_kernel, hipFuncAttributeMaxDynamicSharedMemorySize, LDS_BYTES);
        hipOccupancyMaxActiveBlocksPerMultiprocessor(&per_cu, (const void*)fwd_kernel, 512, LDS_BYTES);
        (void)hipGetLastError();
        grid = cus > 0 ? cus : 256; if (grid > 256) grid = 256;
        if (n_in != 23 || ws_size < WS_END) { fprintf(stderr, "kernel_launch: unexpected n_in %d / ws_size %zu (need %zu)\n", n_in, ws_size, (size_t)WS_END); }
        fprintf(stderr, "kernel_launch: grid %d, occupancy query %d/CU, ws %zu\n", grid, per_cu, ws_size);
    }
    Params p{};
    for (int i = 0; i < 23; ++i) p.in[i] = (const float*)d_in[i];
    p.out = (float*)d_out; p.ws = (unsigned char*)d_ws; p.ph_lo = 0; p.ph_hi = N_PHASES;
    (void)hipMemsetAsync((unsigned char*)d_ws + WS_BAR, 0, XCD_BAR_WORDS * sizeof(unsigned), stream);
    void* args[] = {&p};
    hipError_t e = hipLaunchCooperativeKernel((const void*)fwd_kernel, dim3(grid), dim3(512), args, LDS_BYTES, stream);
    if (e != hipSuccess) fprintf(stderr, "cooperative launch failed: %s (grid %d)\n", hipGetErrorString(e), grid);
}
```

```cpp
#include <hip/hip_runtime.h>
#include <hip/hip_cooperative_groups.h>
#include <cstdio>
namespace cg = cooperative_groups;
namespace pg8 {
#define PG8_LAS __attribute__((address_space(3)))
typedef unsigned short bf16_t;
typedef short bf16x8 __attribute__((ext_vector_type(8)));
typedef float f32x4 __attribute__((ext_vector_type(4)));
typedef unsigned u32x4 __attribute__((ext_vector_type(4)));
constexpr int PADK = 64;
constexpr int BM = 256, BK = 64, HALF = 128, HTB = HALF * BK * 2  , STAGE_BYTES = 8 * HTB, NXCD = 8, WGM = 4;

__host__ __device__ __forceinline__ int lds_byte(int r, int c) { const int st = (r >> 4) * 2 + (c >> 5), rr = r & 15, cc = c & 31, ob = rr * 64 + cc * 2; return st * 1024 + (ob ^ (((ob >> 9) & 1) << 5)); }
__host__ __device__ __forceinline__ void stage_rc(int b, int& R, int& C) { const int st = b / 1024, sb = b % 1024, swz = sb ^ (((sb >> 9) & 1) << 5); R = (st >> 1) * 16 + swz / 64; C = (st & 1) * 32 + (swz % 64) / 2; }
__host__ __device__ __forceinline__ int perm32(int rho) { const int n = rho >> 4, i = rho & 15; return 8 * (i >> 2) + 4 * n + (i & 3); }

struct Unit { int pm, pn; };
struct Gemm { const bf16_t* A; const bf16_t* Bt; int M, N, K; };

struct StaticOrder {
    int nM, nN, nwg, G, c;
    __host__ __device__ void init(int M, int N, int G_, int c_) { nM = M / BM; nN = N / BM; nwg = nM * nN; G = G_; c = c_; }
    __host__ __device__ bool next(int i, Unit& u) const {
        const long L = (long)i * G + c; if (L >= nwg) return false;
        int wgid = (int)L; { const int q = nwg / NXCD, r = nwg % NXCD, xcd = wgid % NXCD, off = wgid / NXCD; wgid = (xcd < r ? xcd * (q + 1) : r * (q + 1) + (xcd - r) * q) + off; }
        const int nig = WGM * nN, gid = wgid / nig, fm = gid * WGM, gsz = (nM - fm) < WGM ? (nM - fm) : WGM;
        u.pm = fm + ((wgid % nig) % gsz); u.pn = (wgid % nig) / gsz; return true;
    }
    __device__ __forceinline__ void a_ready(const Unit&) const {}
    __device__ __forceinline__ void done(const Unit&) const {}
};
__device__ __forceinline__ unsigned cvt_pk_bf16(float lo, float hi) { unsigned r; asm volatile("v_cvt_pk_bf16_f32 %0, %1, %2" : "=v"(r) : "v"(lo), "v"(hi)); return r; }
template <class Epi, class Sched, bool ALIGN_EPI = false, bool SP2 = false>
__device__ __forceinline__ void gemm_phase(PG8_LAS unsigned char* lds, const Gemm g, const Sched& S, const Epi& E) {
    int tid_l = threadIdx.x; asm volatile("" : "+v"(tid_l));
    const int tid = tid_l, wid = __builtin_amdgcn_readfirstlane(tid >> 6), lane = tid & 63, wr = wid >> 2, wc = wid & 3, fr = lane & 15, fq = lane >> 4;
    const int K = g.K, nt = K / BK;
    unsigned voffA[2], voffB[2];
#pragma unroll
    for (int i = 0; i < 2; ++i) { int R, C; stage_rc(tid * 16 + i * 8192, R, C); const int Rb = Epi::PERM ? ((R & ~31) + perm32(R & 31)) : R;
        voffA[i] = (unsigned)(R * (K + PADK) + C) * 2u; voffB[i] = (unsigned)(Rb * (K + PADK) + C) * 2u; }
    const size_t kstep = (size_t)(BK * 2);
    const size_t hstep = (size_t)HALF * (K + PADK) * 2;
    const size_t tstep = 2 * hstep;
    const unsigned ldsw = (unsigned)wid * 1024u;
    const int aoff = lds_byte(wr * 64 + fr, fq * 8), boff = lds_byte(wc * 32 + fr, fq * 8);
#define PG8_SA(b, h) (((b) * 2 + (h)) * HTB)
#define PG8_SB(b, h) ((4 + (b) * 2 + (h)) * HTB)
#define PG8_STAGE(bufoff, gbase, voff) do { _Pragma("unroll") for (int _i = 0; _i < 2; ++_i) \
        __builtin_amdgcn_global_load_lds((const unsigned*)((const char*)(gbase) + (voff)[_i]), (PG8_LAS unsigned*)(lds + (bufoff) + ldsw + _i * 8192), 16, 0, 0); } while (0)
#define PG8_LDA(dst, b, h) do { _Pragma("unroll") for (int m = 0; m < 4; ++m) _Pragma("unroll") for (int k = 0; k < 2; ++k) dst[m][k] = *(const PG8_LAS bf16x8*)(lds + PG8_SA(b, h) + aoff + m * 2048 + k * 1024); } while (0)
#define PG8_LDB(dst, b, h) do { _Pragma("unroll") for (int n = 0; n < 2; ++n) _Pragma("unroll") for (int k = 0; k < 2; ++k) dst[n][k] = *(const PG8_LAS bf16x8*)(lds + PG8_SB(b, h) + boff + n * 2048 + k * 1024); } while (0)
#define PG8_MMA(ai, bj, At, Bt) do { __builtin_amdgcn_s_setprio(1); _Pragma("unroll") for (int m = 0; m < 4; ++m) _Pragma("unroll") for (int n = 0; n < 2; ++n) _Pragma("unroll") for (int k = 0; k < 2; ++k) \
        acc[ai][bj][m][n] = __builtin_amdgcn_mfma_f32_16x16x32_bf16(Bt[n][k], At[m][k], acc[ai][bj][m][n], 0, 0, 0); __builtin_amdgcn_s_setprio(0); } while (0)
#define PG8_WAIT_V(n) asm volatile("s_waitcnt vmcnt(" #n ")" ::: "memory")
#define PG8_WAIT_L(n) asm volatile("s_waitcnt lgkmcnt(" #n ")" ::: "memory")
#define PG8_BAR __builtin_amdgcn_s_barrier()
#define PG8_SCHED __builtin_amdgcn_sched_barrier(0)
    Unit cur, nxt; int ui = 0;
    if (!S.next(0, cur)) return;
    f32x4 acc[2][2][4][2];
#pragma unroll
    for (int a = 0; a < 2; ++a)
#pragma unroll
        for (int b = 0; b < 2; ++b)
#pragma unroll
            for (int m = 0; m < 4; ++m)
#pragma unroll
                for (int n = 0; n < 2; ++n) acc[a][b][m][n] = (f32x4){0.f, 0.f, 0.f, 0.f};
    bf16x8 At[4][2], B0[2][2], B1[2][2];
    const char* cA = (const char*)g.A + (size_t)cur.pm * tstep; const char* cB = (const char*)g.Bt + (size_t)cur.pn * tstep;
    S.a_ready(cur);
    if constexpr (SP2) {
        PG8_STAGE(PG8_SB(0, 0), cB, voffB); PG8_STAGE(PG8_SB(0, 1), cB + hstep, voffB); PG8_STAGE(PG8_SA(0, 0), cA, voffA); PG8_STAGE(PG8_SA(0, 1), cA + hstep, voffA);
        if (wr == 1) PG8_BAR;
        PG8_WAIT_V(2); PG8_BAR;
        PG8_STAGE(PG8_SB(1, 0), cB + kstep, voffB); PG8_STAGE(PG8_SA(1, 0), cA + kstep, voffA); PG8_STAGE(PG8_SB(1, 1), cB + hstep + kstep, voffB);
        PG8_WAIT_V(6); PG8_BAR;
    } else {
        PG8_STAGE(PG8_SB(0, 0), cB, voffB); PG8_STAGE(PG8_SA(0, 0), cA, voffA); PG8_STAGE(PG8_SB(0, 1), cB + hstep, voffB); PG8_STAGE(PG8_SA(0, 1), cA + hstep, voffA);
        if (wr == 1) PG8_BAR;
        PG8_WAIT_V(4); PG8_BAR;
        PG8_STAGE(PG8_SB(1, 0), cB + kstep, voffB); PG8_STAGE(PG8_SA(1, 0), cA + kstep, voffA); PG8_STAGE(PG8_SB(1, 1), cB + hstep + kstep, voffB);
        PG8_WAIT_V(6); PG8_BAR;
    }
    for (;;) {
        const bool has_next = S.next(ui + 1, nxt);
        const char* nA = has_next ? (const char*)g.A + (size_t)nxt.pm * tstep : cA; const char* nB = has_next ? (const char*)g.Bt + (size_t)nxt.pn * tstep : cB;
        for (int t = 0; t < nt; t += 2) {
            const bool last = (t == nt - 2);
            const char* a1 = cA + (size_t)(t + 1) * kstep;
            const char* a2 = last ? nA : cA + (size_t)(t + 2) * kstep; const char* b2 = last ? nB : cB + (size_t)(t + 2) * kstep;
            const char* a3 = a2 + kstep; const char* b3 = b2 + kstep;
            if (last && has_next) S.a_ready(nxt);
            if constexpr (SP2) {
            PG8_LDB(B0, 0, 0); PG8_LDB(B1, 0, 1); PG8_SCHED; PG8_LDA(At, 0, 0); PG8_STAGE(PG8_SA(1, 1), a1 + hstep, voffA);
            PG8_WAIT_V(8); PG8_WAIT_L(0); PG8_BAR; PG8_MMA(0, 0, At, B0); PG8_MMA(0, 1, At, B1); PG8_BAR; PG8_SCHED;
            PG8_LDA(At, 0, 1); PG8_STAGE(PG8_SB(0, 0), b2, voffB); PG8_STAGE(PG8_SB(0, 1), b2 + hstep, voffB); PG8_STAGE(PG8_SA(0, 0), a2, voffA);
            PG8_WAIT_V(8); PG8_WAIT_L(0); PG8_BAR; PG8_MMA(1, 0, At, B0); PG8_MMA(1, 1, At, B1); PG8_BAR; PG8_SCHED;
            PG8_LDB(B0, 1, 0); PG8_LDB(B1, 1, 1); PG8_SCHED; PG8_LDA(At, 1, 0); PG8_STAGE(PG8_SA(0, 1), a2 + hstep, voffA);
            PG8_WAIT_V(8); PG8_WAIT_L(0); PG8_BAR; PG8_MMA(0, 0, At, B0); PG8_MMA(0, 1, At, B1); PG8_BAR; PG8_SCHED;
            PG8_LDA(At, 1, 1); PG8_STAGE(PG8_SB(1, 0), b3, voffB); PG8_STAGE(PG8_SB(1, 1), b3 + hstep, voffB); PG8_STAGE(PG8_SA(1, 0), a3, voffA);
            PG8_WAIT_V(8); PG8_WAIT_L(0); PG8_BAR; PG8_MMA(1, 0, At, B0); PG8_MMA(1, 1, At, B1); PG8_BAR; PG8_SCHED;
            } else {
            PG8_LDB(B0, 0, 0); PG8_SCHED; PG8_LDA(At, 0, 0); PG8_STAGE(PG8_SA(1, 1), a1 + hstep, voffA);
            PG8_WAIT_L(8); PG8_BAR; PG8_WAIT_L(0); PG8_MMA(0, 0, At, B0); PG8_BAR; PG8_SCHED;
            PG8_LDB(B1, 0, 1); PG8_STAGE(PG8_SB(0, 0), b2, voffB);
            PG8_BAR; PG8_WAIT_L(0); PG8_MMA(0, 1, At, B1); PG8_BAR;
            PG8_LDA(At, 0, 1); PG8_STAGE(PG8_SA(0, 0), a2, voffA);
            PG8_BAR; PG8_WAIT_L(0); PG8_MMA(1, 0, At, B0); PG8_BAR; PG8_SCHED;
            PG8_STAGE(PG8_SB(0, 1), b2 + hstep, voffB);
            PG8_WAIT_V(6); PG8_BAR; PG8_MMA(1, 1, At, B1); PG8_BAR;
            PG8_LDB(B0, 1, 0); PG8_SCHED; PG8_LDA(At, 1, 0); PG8_STAGE(PG8_SA(0, 1), a2 + hstep, voffA);
            PG8_WAIT_L(8); PG8_BAR; PG8_WAIT_L(0); PG8_MMA(0, 0, At, B0); PG8_BAR; PG8_SCHED;
            PG8_LDB(B1, 1, 1); PG8_STAGE(PG8_SB(1, 0), b3, voffB);
            PG8_BAR; PG8_WAIT_L(0); PG8_MMA(0, 1, At, B1); PG8_BAR;
            PG8_LDA(At, 1, 1); PG8_STAGE(PG8_SA(1, 0), a3, voffA);
            PG8_BAR; PG8_WAIT_L(0); PG8_MMA(1, 0, At, B0); PG8_BAR; PG8_SCHED;
            PG8_STAGE(PG8_SB(1, 1), b3 + hstep, voffB);
            PG8_WAIT_V(6); PG8_BAR; PG8_MMA(1, 1, At, B1); PG8_BAR;
            }
        }
        if constexpr (ALIGN_EPI) { if (wr == 0) PG8_BAR; }
        if constexpr (!Epi::AFTER_DRAIN) { E(acc, cur, wr, wc, fr, fq); S.done(cur); }
        if (!has_next) break;
#pragma unroll
        for (int a = 0; a < 2; ++a)
#pragma unroll
            for (int b = 0; b < 2; ++b)
#pragma unroll
                for (int m = 0; m < 4; ++m)
#pragma unroll
                    for (int n = 0; n < 2; ++n) acc[a][b][m][n] = (f32x4){0.f, 0.f, 0.f, 0.f};
        cur = nxt; cA = nA; cB = nB; ++ui;
        if constexpr (ALIGN_EPI) { if (wr == 1) PG8_BAR; }
    }
    PG8_WAIT_V(0);
    if constexpr (!ALIGN_EPI) { if (wr == 0) PG8_BAR; }
    PG8_BAR;
    if constexpr (Epi::AFTER_DRAIN) { E.fused(acc, cur, wr, wc, fr, fq, lds, wid, lane); S.done(cur); }
#undef PG8_SA
#undef PG8_SB
#undef PG8_STAGE
#undef PG8_LDA
#undef PG8_LDB
#undef PG8_MMA
#undef PG8_WAIT_V
#undef PG8_WAIT_L
#undef PG8_BAR
#undef PG8_SCHED
}
}

#define LAS __attribute__((address_space(3)))
typedef unsigned short bf16_t;
typedef float f32x4 __attribute__((ext_vector_type(4)));
typedef unsigned u32x4 __attribute__((ext_vector_type(4)));
typedef unsigned u32x2 __attribute__((ext_vector_type(2)));
typedef short bf16x8 __attribute__((ext_vector_type(8)));
typedef short bf16x4 __attribute__((ext_vector_type(4)));

constexpr int NTOK = 65536, DM = 2048, NPROMPT = 32768, DFF = 8192;
constexpr int PX = DM + 64, PH = DFF + 64;
constexpr float EPS = 1e-5f;
constexpr size_t MiB = 1u << 20;
constexpr size_t WS_RSTDX = 0, WS_SSH = 256 * 1024, WS_SSF = 512 * 1024, WS_TW = 768 * 1024;
constexpr size_t WS_H3A = 1 * MiB, WS_H3B = 2 * MiB;
constexpr size_t WS_WIN = 4 * MiB, WS_WOUT = 29 * MiB, WS_WUP = 38 * MiB, WS_WDN = 71 * MiB, WS_KH = 104 * MiB, WS_UT = 168 * MiB, WS_QKV = 552 * MiB, WS_ZA = 936 * MiB, WS_BAR = 968 * MiB, WS_END = 969 * MiB;
constexpr size_t WS_MIX = WS_UT, WS_HB = 620 * MiB, WS_HID = 104 * MiB;
constexpr size_t DO_XB = 0, DO_YT = 256 * MiB, DO_YNAT = 384 * MiB;
constexpr int LDS_BYTES = 147456;
constexpr int FFN_CHUNK = 32768, N_CHUNK = NTOK / FFN_CHUNK;
constexpr int N_PHASES = 5 + 2 * N_CHUNK + 1;

struct Params { const float* in[23]; float* out; unsigned char* ws; int ph_lo, ph_hi; };

__device__ __forceinline__ float wave_sum(float v) {
#pragma unroll
    for (int o = 1; o < 64; o <<= 1) v += __shfl_xor(v, o);
    return v;
}
__device__ __forceinline__ unsigned pk2(float lo, float hi) { return pg8::cvt_pk_bf16(lo, hi); }
__device__ __forceinline__ float bf2f(unsigned short b) { return __uint_as_float(((unsigned)b) << 16); }
__device__ __forceinline__ float bflo(unsigned w) { return __uint_as_float(w << 16); }
__device__ __forceinline__ float bfhi(unsigned w) { return __uint_as_float(w & 0xffff0000u); }

struct EpiUT {
    static constexpr bool PERM = true, AFTER_DRAIN = false;
    bf16_t* O; const float* rstd;
    __device__ __forceinline__ void operator()(const f32x4 (&acc)[2][2][4][2], const pg8::Unit& u, int wr, int wc, int fr, int fq) const {
        const int row0 = u.pm * 256 + wr * 64 + fr, col0 = u.pn * 256 + wc * 32 + 8 * fq;
#pragma unroll
        for (int ai = 0; ai < 2; ++ai)
#pragma unroll
            for (int m = 0; m < 4; ++m) { bf16_t* rowp = O + (size_t)(row0 + ai * 128 + m * 16) * NTOK + col0;
#pragma unroll
                for (int bj = 0; bj < 2; ++bj) { const f32x4 v0 = acc[ai][bj][m][0], v1 = acc[ai][bj][m][1];
                    u32x4 w; w.x = pk2(v0[0], v0[1]); w.y = pk2(v0[2], v0[3]); w.z = pk2(v1[0], v1[1]); w.w = pk2(v1[2], v1[3]);
                    *(u32x4*)(rowp + bj * 128) = w; } }
    }
};
struct EpiQKV {
    static constexpr bool PERM = true, AFTER_DRAIN = false;
    bf16_t* O; const float* rstd;
    __device__ __forceinline__ void operator()(const f32x4 (&acc)[2][2][4][2], const pg8::Unit& u, int wr, int wc, int fr, int fq) const {
        const int row0 = u.pm * 256 + wr * 64 + fr, col0 = u.pn * 256 + wc * 32 + 8 * fq;
#pragma unroll
        for (int ai = 0; ai < 2; ++ai)
#pragma unroll
            for (int m = 0; m < 4; ++m) { const int row = row0 + ai * 128 + m * 16; bf16_t* rowp = O + (size_t)row * 3072 + col0;
#pragma unroll
                for (int bj = 0; bj < 2; ++bj) { const f32x4 v0 = acc[ai][bj][m][0], v1 = acc[ai][bj][m][1];
                    u32x4 w; w.x = pk2(v0[0], v0[1]); w.y = pk2(v0[2], v0[3]); w.z = pk2(v1[0], v1[1]); w.w = pk2(v1[2], v1[3]);
                    *(u32x4*)(rowp + bj * 128) = w; } }
    }
};
struct EpiH {
    static constexpr bool PERM = true, AFTER_DRAIN = false;
    const float* xp; const float* xs; float* H; bf16_t* HB; float* ss;
    __device__ __forceinline__ void operator()(const f32x4 (&acc)[2][2][4][2], const pg8::Unit& u, int wr, int wc, int fr, int fq) const {
        const int row0 = u.pm * 256 + wr * 64 + fr, col0 = u.pn * 256 + wc * 32 + 8 * fq;
#pragma unroll
        for (int ai = 0; ai < 2; ++ai) {
            f32x4 xv[4][2][2];
#pragma unroll
            for (int m = 0; m < 4; ++m) { const int row = row0 + ai * 128 + m * 16;
                const float* xr = (row < NPROMPT ? xp + (size_t)row * DM : xs + (size_t)(row - NPROMPT) * DM) + col0;
#pragma unroll
                for (int bj = 0; bj < 2; ++bj) { xv[m][bj][0] = *(const f32x4*)(xr + bj * 128); xv[m][bj][1] = *(const f32x4*)(xr + bj * 128 + 4); } }
#pragma unroll
            for (int m = 0; m < 4; ++m) { const int row = row0 + ai * 128 + m * 16; bf16_t* br = HB + (size_t)row * PX + col0; float q = 0.f;
#pragma unroll
                for (int bj = 0; bj < 2; ++bj) { const f32x4 v0 = acc[ai][bj][m][0] + xv[m][bj][0], v1 = acc[ai][bj][m][1] + xv[m][bj][1];
                    u32x4 w; w.x = pk2(v0[0], v0[1]); w.y = pk2(v0[2], v0[3]); w.z = pk2(v1[0], v1[1]); w.w = pk2(v1[2], v1[3]);
                    *(u32x4*)(br + bj * 128) = w;
                    q += (v0[0] * v0[0] + v0[1] * v0[1]) + (v0[2] * v0[2] + v0[3] * v0[3]) + (v1[0] * v1[0] + v1[1] * v1[1]) + (v1[2] * v1[2] + v1[3] * v1[3]); }
                q += __shfl_xor(q, 16); q += __shfl_xor(q, 32);
                if (fq == 0) atomicAdd(ss + row, q); }
            asm volatile("" ::: "memory");
        }
    }
};
struct EpiUp {
    static constexpr bool PERM = true, AFTER_DRAIN = false;
    bf16_t* O; const float* ss;
    __device__ __forceinline__ void operator()(const f32x4 (&acc)[2][2][4][2], const pg8::Unit& u, int wr, int wc, int fr, int fq) const {
        const int row0 = u.pm * 256 + wr * 64 + fr, col0 = u.pn * 256 + wc * 32 + 8 * fq;
#pragma unroll
        for (int ai = 0; ai < 2; ++ai)
#pragma unroll
            for (int m = 0; m < 4; ++m) { const int row = row0 + ai * 128 + m * 16; bf16_t* rowp = O + (size_t)row * PH + col0;
#pragma unroll
                for (int bj = 0; bj < 2; ++bj) { f32x4 v0 = acc[ai][bj][m][0], v1 = acc[ai][bj][m][1];
#pragma unroll
                    for (int e = 0; e < 4; ++e) { const float a = fmaxf(v0[e], 0.f), b = fmaxf(v1[e], 0.f); v0[e] = a * a; v1[e] = b * b; }
                    u32x4 w; w.x = pk2(v0[0], v0[1]); w.y = pk2(v0[2], v0[3]); w.z = pk2(v1[0], v1[1]); w.w = pk2(v1[2], v1[3]);
                    *(u32x4*)(rowp + bj * 128) = w; } }
    }
};
struct EpiDown {
    static constexpr bool PERM = true, AFTER_DRAIN = false;
    bf16_t* HB; float* ss; const float* ssh;
    __device__ __forceinline__ void operator()(const f32x4 (&acc)[2][2][4][2], const pg8::Unit& u, int wr, int wc, int fr, int fq) const {
        const int row0 = u.pm * 256 + wr * 64 + fr, col0 = u.pn * 256 + wc * 32 + 8 * fq;
        u32x4 hw[2][4][2]; float s2[2][4];
#pragma unroll
        for (int ai = 0; ai < 2; ++ai)
#pragma unroll
            for (int m = 0; m < 4; ++m) { const int row = row0 + ai * 128 + m * 16; const bf16_t* br = HB + (size_t)row * PX + col0;
                hw[ai][m][0] = *(const u32x4*)br; hw[ai][m][1] = *(const u32x4*)(br + 128); s2[ai][m] = ssh[row]; }
#pragma unroll
        for (int ai = 0; ai < 2; ++ai)
#pragma unroll
            for (int m = 0; m < 4; ++m) { const int row = row0 + ai * 128 + m * 16; bf16_t* br = HB + (size_t)row * PX + col0; float q = 0.f; const float sc = 1.0f / (s2[ai][m] * (1.0f / DM) + EPS);
#pragma unroll
                for (int bj = 0; bj < 2; ++bj) { const u32x4 h = hw[ai][m][bj];
                    const f32x4 x0 = {bflo(h.x), bfhi(h.x), bflo(h.y), bfhi(h.y)}, x1 = {bflo(h.z), bfhi(h.z), bflo(h.w), bfhi(h.w)};
                    const f32x4 v0 = acc[ai][bj][m][0] * sc + x0, v1 = acc[ai][bj][m][1] * sc + x1;
                    u32x4 w; w.x = pk2(v0[0], v0[1]); w.y = pk2(v0[2], v0[3]); w.z = pk2(v1[0], v1[1]); w.w = pk2(v1[2], v1[3]);
                    *(u32x4*)(br + bj * 128) = w;
                    q += (v0[0] * v0[0] + v0[1] * v0[1]) + (v0[2] * v0[2] + v0[3] * v0[3]) + (v1[0] * v1[0] + v1[1] * v1[1]) + (v1[2] * v1[2] + v1[3] * v1[3]); }
                q += __shfl_xor(q, 16); q += __shfl_xor(q, 32);
                if (fq == 0) atomicAdd(ss + row, q); }
    }
};

__device__ __forceinline__ void transpose_item(const float* W, const float* g, int K, int N, bf16_t* WT, float* scr, int item, int lane) {
    const int nblk = N / 32, kb = item / nblk, nb = item % nblk, k0 = 64 * kb, n0 = 32 * nb;
#pragma unroll
    for (int i = 0; i < 8; ++i) { const int kk = 8 * i + (lane >> 3), nn = (lane & 7) * 4; const float sc = g ? g[k0 + kk] : 1.0f;
        const f32x4 w = *(const f32x4*)(W + (size_t)(k0 + kk) * N + n0 + nn) * sc; float* d = scr + kk * 33 + nn; d[0] = w[0]; d[1] = w[1]; d[2] = w[2]; d[3] = w[3]; }
    __builtin_amdgcn_s_waitcnt(0); __builtin_amdgcn_wave_barrier();
    const int c = lane & 7;
#pragma unroll
    for (int j = 0; j < 4; ++j) { const int n = (lane >> 3) + 8 * j; const float* s = scr + (8 * c) * 33 + n;
        u32x4 o; o.x = pk2(s[0 * 33], s[1 * 33]); o.y = pk2(s[2 * 33], s[3 * 33]); o.z = pk2(s[4 * 33], s[5 * 33]); o.w = pk2(s[6 * 33], s[7 * 33]);
        *(u32x4*)(WT + (size_t)(n0 + n) * (K + 64) + k0 + 8 * c) = o; }
    __builtin_amdgcn_s_waitcnt(0); __builtin_amdgcn_wave_barrier();
}

__device__ __forceinline__ void phase_prep(const Params& p, unsigned char* lds_raw) {
    unsigned char* ws = p.ws;
    const int tid = threadIdx.x, lane = tid & 63, wave = tid >> 6;
    const int gw = blockIdx.x * 8 + wave, NGW = gridDim.x * 8;
    const int gt = blockIdx.x * 512 + tid, NGT = gridDim.x * 512;
    { float* z1 = (float*)(ws + WS_SSH); float* z2 = (float*)(ws + WS_SSF);
      for (int i = gt; i < NTOK; i += NGT) { z1[i] = 0.f; z2[i] = 0.f; } }
    { float2* T = (float2*)(ws + WS_TW);
      for (int j = gt; j < 8192; j += NGT) { float s, c; sincospif((float)j * (1.0f / 8192.0f), &s, &c); T[j] = make_float2(c, -s); } }
    { bf16_t* xb = (bf16_t*)((unsigned char*)p.out + DO_XB); float* rstd = (float*)(ws + WS_RSTDX);
      for (int row = gw; row < NTOK; row += 2 * NGW) {
          const int r1 = row + NGW < NTOK ? row + NGW : row;
          const float* xr0 = row < NPROMPT ? p.in[0] + (size_t)row * DM : p.in[1] + (size_t)(row - NPROMPT) * DM;
          const float* xr1 = r1 < NPROMPT ? p.in[0] + (size_t)r1 * DM : p.in[1] + (size_t)(r1 - NPROMPT) * DM;
          f32x4 v0[8], v1[8]; float s0 = 0.f, s1 = 0.f;
#pragma unroll
          for (int j = 0; j < 8; ++j) { v0[j] = ((const f32x4*)xr0)[lane + 64 * j]; v1[j] = ((const f32x4*)xr1)[lane + 64 * j]; }
#pragma unroll
          for (int j = 0; j < 8; ++j) { s0 += (v0[j][0] * v0[j][0] + v0[j][1] * v0[j][1]) + (v0[j][2] * v0[j][2] + v0[j][3] * v0[j][3]); s1 += (v1[j][0] * v1[j][0] + v1[j][1] * v1[j][1]) + (v1[j][2] * v1[j][2] + v1[j][3] * v1[j][3]); }
          s0 = wave_sum(s0); s1 = wave_sum(s1);
          const float rs0 = 1.0f / sqrtf(s0 * (1.0f / DM) + EPS), rs1 = 1.0f / sqrtf(s1 * (1.0f / DM) + EPS);
          if (lane == 0) { rstd[row] = rs0; rstd[r1] = rs1; }
          u32x2* o0 = (u32x2*)(xb + (size_t)row * PX); u32x2* o1 = (u32x2*)(xb + (size_t)r1 * PX);
#pragma unroll
          for (int j = 0; j < 8; ++j) { u32x2 w; w.x = pk2(v0[j][0] * rs0, v0[j][1] * rs0); w.y = pk2(v0[j][2] * rs0, v0[j][3] * rs0); o0[lane + 64 * j] = w;
              u32x2 u; u.x = pk2(v1[j][0] * rs1, v1[j][1] * rs1); u.y = pk2(v1[j][2] * rs1, v1[j][3] * rs1); o1[lane + 64 * j] = u; }
      } }
    { float* scr = (float*)(lds_raw + wave * 16384);
      constexpr int I_IN = (DM / 64) * (6144 / 32), I_OUT = (DM / 64) * (DM / 32), I_UP = (DM / 64) * (DFF / 32), I_DN = (DFF / 64) * (DM / 32);
      for (int it = gw; it < I_IN + I_OUT + I_UP + I_DN; it += NGW) {
          int r = it;
          if (r < I_IN) { transpose_item(p.in[3], p.in[2], DM, 6144, (bf16_t*)(ws + WS_WIN), scr, r, lane); continue; } r -= I_IN;
          if (r < I_OUT) { transpose_item(p.in[18], nullptr, DM, DM, (bf16_t*)(ws + WS_WOUT), scr, r, lane); continue; } r -= I_OUT;
          if (r < I_UP) { transpose_item(p.in[20], p.in[19], DM, DFF, (bf16_t*)(ws + WS_WUP), scr, r, lane); continue; } r -= I_UP;
          transpose_item(p.in[21], nullptr, DFF, DM, (bf16_t*)(ws + WS_WDN), scr, r, lane);
      } }
    { const float* w1 = p.in[6]; const float* b1 = p.in[7]; const float* w2 = p.in[8]; const float* b2 = p.in[9]; const float* w3 = p.in[10]; const float* b3 = p.in[11]; const float* fr = p.in[12];
      const float frl = fr[lane];
      for (int it = gw; it < 4096 + 8192; it += NGW) {
          int L, t; bf16_t* h3;
          if (it < 4096) { L = 4096; t = it; h3 = (bf16_t*)(ws + WS_H3A); } else { L = 8192; t = it - 4096; h3 = (bf16_t*)(ws + WS_H3B); }
          const float tl = (float)t / (float)(L - 1);
          const float tpl = 2.0f * (float)t / (float)L;
          float a = tl * w1[lane];
#pragma unroll 4
          for (int b = 0; b < 16; ++b) { const float f = 1e-4f + (float)b * ((15.0f - 1e-4f) / 15.0f); float sn, cn; sincospif(tpl * f, &sn, &cn);
              a += cn * w1[(1 + b) * 64 + lane]; a -= sn * w1[(17 + b) * 64 + lane]; }
          float h = sinf(frl * (a + b1[lane]));
          a = 0.f;
#pragma unroll 8
          for (int i = 0; i < 64; ++i) a += __shfl(h, i) * w2[i * 64 + lane];
          h = sinf(frl * (a + b2[lane]));
          a = 0.f;
#pragma unroll 8
          for (int i = 0; i < 64; ++i) a += __shfl(h, i) * w3[i * 64 + lane];
          h = sinf(frl * (a + b3[lane]));
          h3[(size_t)lane * L + t] = (bf16_t)(pk2(h, 0.f) & 0xffffu);
      } }
}

typedef float c32 __attribute__((ext_vector_type(2)));
constexpr int LDS_TW = 73728, LDS_W4C = 139264;
__device__ __forceinline__ int PD(int i) { return i ^ ((i >> 5) & 7) ^ (((i >> 6) & 3) << 3); }
__device__ __forceinline__ c32 mk(float x, float y) { return (c32){x, y}; }
__device__ __forceinline__ c32 cmul(c32 a, c32 w) { return __builtin_shufflevector(a, a, 0, 0) * w + __builtin_shufflevector(a, a, 1, 1) * (c32){-w.y, w.x}; }
__device__ __forceinline__ c32 cmulc(c32 a, c32 w) { return __builtin_shufflevector(a, a, 0, 0) * (c32){w.x, -w.y} + __builtin_shufflevector(a, a, 1, 1) * (c32){w.y, w.x}; }
template <int S_HI, int NST>
__device__ __forceinline__ void fwd_group(c32 (&e)[1 << NST], const c32* TW, int low) {
    constexpr int R = 1 << NST, S_LO = S_HI - NST + 1;
#pragma unroll
    for (int t = 0; t < NST; ++t) {
        const int s = S_HI - t, kd = R >> (t + 1);
#pragma unroll
        for (int k = 0; k < R; ++k) if (!(k & kd)) {
            const c32 w = TW[(1 << s) + low + ((k & (kd - 1)) << S_LO)];
            const c32 a = e[k], b = e[k + kd];
            e[k] = a + b;
            e[k + kd] = cmul(a - b, w);
        }
    }
}
template <int S_HI, int NST>
__device__ __forceinline__ void inv_group(c32 (&e)[1 << NST], const c32* TW, int low) {
    constexpr int R = 1 << NST, S_LO = S_HI - NST + 1;
#pragma unroll
    for (int t = 0; t < NST; ++t) {
        const int s = S_LO + t, kd = 1 << t;
#pragma unroll
        for (int k = 0; k < R; ++k) if (!(k & kd)) {
            const c32 w = TW[(1 << s) + low + ((k & (kd - 1)) << S_LO)];
            const c32 a = e[k], b = cmulc(e[k + kd], w);
            e[k] = a + b;
            e[k + kd] = a - b;
        }
    }
}
__device__ __forceinline__ c32 mul_w8(c32 a, int k) {
    constexpr float r = 0.70710678118654752f;
    return k == 0 ? a : k == 1 ? mk((a.x + a.y) * r, (a.y - a.x) * r) : k == 2 ? mk(a.y, -a.x) : mk((a.y - a.x) * r, -(a.x + a.y) * r);
}
__device__ __forceinline__ c32 mul_w8c(c32 a, int k) {
    constexpr float r = 0.70710678118654752f;
    return k == 0 ? a : k == 1 ? mk((a.x - a.y) * r, (a.x + a.y) * r) : k == 2 ? mk(-a.y, a.x) : mk(-(a.x + a.y) * r, (a.x - a.y) * r);
}
__device__ __forceinline__ void fwd8_const(c32 (&e)[8]) {
#pragma unroll
    for (int k = 0; k < 4; ++k) { const c32 a = e[k], b = e[k + 4]; e[k] = a + b; e[k + 4] = mul_w8(a - b, k); }
#pragma unroll
    for (int h = 0; h < 2; ++h)
#pragma unroll
        for (int k = 0; k < 2; ++k) { const c32 a = e[4 * h + k], b = e[4 * h + k + 2]; e[4 * h + k] = a + b; e[4 * h + k + 2] = mul_w8(a - b, 2 * k); }
#pragma unroll
    for (int k = 0; k < 8; k += 2) { const c32 a = e[k], b = e[k + 1]; e[k] = a + b; e[k + 1] = a - b; }
}
__device__ __forceinline__ void inv8_const(c32 (&e)[8]) {
#pragma unroll
    for (int k = 0; k < 8; k += 2) { const c32 a = e[k], b = e[k + 1]; e[k] = a + b; e[k + 1] = a - b; }
#pragma unroll
    for (int h = 0; h < 2; ++h)
#pragma unroll
        for (int k = 0; k < 2; ++k) { const c32 a = e[4 * h + k], b = mul_w8c(e[4 * h + k + 2], 2 * k); e[4 * h + k] = a + b; e[4 * h + k + 2] = a - b; }
#pragma unroll
    for (int k = 0; k < 4; ++k) { const c32 a = e[k], b = mul_w8c(e[k + 4], k); e[k] = a + b; e[k + 4] = a - b; }
}
template <int LOG, int S_HI, bool INV>
__device__ __forceinline__ void pass8(c32* D, const c32* TW, int tid) {
    asm volatile("" : "+v"(tid));
    constexpr int L = 1 << LOG, S_LO = S_HI - 2, NGT = L / 8 / 512;
#pragma unroll
    for (int gi = 0; gi < NGT; ++gi) {
        const int g = tid + 512 * gi, low = g & ((1 << S_LO) - 1), base = ((g >> S_LO) << (S_HI + 1)) | low;
        c32 e[8];
#pragma unroll
        for (int k = 0; k < 8; ++k) e[k] = D[PD(base + (k << S_LO))];
        if (INV) inv_group<S_HI, 3>(e, TW, low); else fwd_group<S_HI, 3>(e, TW, low);
#pragma unroll
        for (int k = 0; k < 8; ++k) D[PD(base + (k << S_LO))] = e[k];
    }
}
template <int LOG>
__device__ __forceinline__ void fusedK(c32* D, const c32* TW, const c32* K, int tid) {
    asm volatile("" : "+v"(tid));
    constexpr int L = 1 << LOG, NGT = L / 8 / 512;
#pragma unroll
    for (int gi = 0; gi < NGT; ++gi) {
        const int g = tid + 512 * gi, base = g * 8;
        const f32x4* kp = (const f32x4*)(K + base);
        f32x4 kk[4];
#pragma unroll
        for (int j = 0; j < 4; ++j) kk[j] = kp[j];
        c32 e[8];
#pragma unroll
        for (int k = 0; k < 8; ++k) e[k] = D[PD(base + k)];
        fwd8_const(e);
#pragma unroll
        for (int k = 0; k < 8; ++k) e[k] = cmul(e[k], mk(kk[k >> 1][(k & 1) * 2], kk[k >> 1][(k & 1) * 2 + 1]));
        inv8_const(e);
#pragma unroll
        for (int k = 0; k < 8; ++k) D[PD(base + k)] = e[k];
    }
}
template <int LOG>
__device__ __forceinline__ void filt_last(c32* D, const c32* TW, c32* K, float bo, int tid) {
    asm volatile("" : "+v"(tid));
    constexpr int L = 1 << LOG, NGT = L / 8 / 512;
#pragma unroll
    for (int gi = 0; gi < NGT; ++gi) {
        const int g = tid + 512 * gi, base = g * 8;
        c32 e[8];
#pragma unroll
        for (int k = 0; k < 8; ++k) e[k] = D[PD(base + k)];
        fwd8_const(e);
        f32x4* kp = (f32x4*)(K + base);
#pragma unroll
        for (int j = 0; j < 4; ++j) kp[j] = (f32x4){e[2 * j].x + bo, e[2 * j].y, e[2 * j + 1].x + bo, e[2 * j + 1].y};
    }
}
__device__ __forceinline__ void lds_barrier() { asm volatile("s_waitcnt lgkmcnt(0)\n\ts_barrier" ::: "memory"); }
template <int LOG>
__device__ __forceinline__ void fft_head(c32 (&e)[1 << (LOG - 9)], c32* D, const c32* TW, int tid) {
    asm volatile("" : "+v"(tid));
    constexpr int NE = 1 << (LOG - 9);
    fwd_group<LOG - 1, LOG - 9>(e, TW, tid);
#pragma unroll
    for (int k = 0; k < NE; ++k) D[PD(tid) + 512 * k] = e[k];
    lds_barrier();
    pass8<LOG, 8, false>(D, TW, tid);
    lds_barrier();
    pass8<LOG, 5, false>(D, TW, tid);
    lds_barrier();
}
template <int LOG>
__device__ __forceinline__ void fft_tail(c32 (&e)[1 << (LOG - 9)], c32* D, const c32* TW, int tid) {
    asm volatile("" : "+v"(tid));
    constexpr int NE = 1 << (LOG - 9);
    lds_barrier();
    pass8<LOG, 5, true>(D, TW, tid);
    lds_barrier();
    pass8<LOG, 8, true>(D, TW, tid);
    lds_barrier();
#pragma unroll
    for (int k = 0; k < NE; ++k) e[k] = D[PD(tid) + 512 * k];
    inv_group<LOG - 1, LOG - 9>(e, TW, tid);
}
__device__ __forceinline__ float sconv(const bf16_t* base, int n, int L, float w0, float w1, float w2, float b) {
    const float l = n > 0 ? bf2f(base[n - 1]) : 0.f, m = bf2f(base[n]), r = n < L - 1 ? bf2f(base[n + 1]) : 0.f;
    return w0 * l + w1 * m + w2 * r + b;
}
template <int LOG>
__device__ __forceinline__ void stage_load(const bf16_t* b0, u32x4 (&v)[(1 << LOG) / 2048], int tid) {
    constexpr int L = 1 << LOG, NCH = L / 2048;
#pragma unroll
    for (int i = 0; i < NCH; ++i) { const int q = tid + 512 * i, row = q >> (LOG - 3), ch = q & ((L >> 3) - 1); v[i] = *(const u32x4*)(b0 + (size_t)row * L + ch * 8); }
}
template <int LOG>
__device__ __forceinline__ void stage_store(const u32x4 (&v)[(1 << LOG) / 2048], bf16_t* S, int tid) {
    constexpr int L = 1 << LOG, NCH = L / 2048;
#pragma unroll
    for (int i = 0; i < NCH; ++i) { const int q = tid + 512 * i, row = q >> (LOG - 3), ch = q & ((L >> 3) - 1); *(u32x4*)(S + row * (L + 16) + 8 + ch * 8) = v[i]; }
    if (tid < 2) { S[tid * (L + 16) + 7] = 0; S[tid * (L + 16) + 8 + L] = 0; }
}
__device__ __forceinline__ float sconvS(const bf16_t* S, int n, float w0, float w1, float w2, float b) {
    return w0 * bf2f(S[n - 1]) + w1 * bf2f(S[n]) + w2 * bf2f(S[n + 1]) + b;
}
template <int LOG>
__device__ __forceinline__ void hyena_item(const Params& p, int c, unsigned char* lds_raw, bool fill_tw) {
    constexpr int L = 1 << LOG, NE = L / 512, MS = 13 - LOG;
    constexpr int NB = (LOG == 13) ? 4 : 8, TOK0 = (LOG == 13) ? NPROMPT : 0;
    unsigned char* ws = p.ws;
    c32* D = (c32*)lds_raw; c32* TW = (c32*)(lds_raw + LDS_TW);
    const c32* T = (const c32*)(ws + WS_TW);
    const bf16_t* h3 = (const bf16_t*)(ws + (LOG == 13 ? WS_H3B : WS_H3A));
    c32* Kb = (c32*)(ws + WS_KH + (size_t)blockIdx.x * 262144);
    c32* Zg = (c32*)(ws + WS_ZA + (size_t)blockIdx.x * 131072); c32* Ag = Zg + L;
    const bf16_t* uT = (const bf16_t*)(ws + WS_UT);
    bf16_t* yT = (bf16_t*)((unsigned char*)p.out + DO_YT);
    const float* convw = p.in[4]; const float* convb = p.in[5]; const float* w4 = p.in[13]; const float* hbias = p.in[14];
    int tid = threadIdx.x;
    if (fill_tw) { for (int idx = tid; idx < L; idx += 512) { const int s = 31 - __clz(idx | 1), pos = idx - (1 << s); TW[idx] = T[pos << (13 - s)]; } }
    float* W4C = (float*)(lds_raw + LDS_W4C);
    if (tid < 256) W4C[tid] = w4[(size_t)(tid >> 2) * 4096 + (tid & 3) * 1024 + c];
    __syncthreads();
    const float adel = 3.0701134573253945f + (float)c * (12.280453829301578f / 1023.0f);
    { float* HF = (float*)D; float* HBk = HF + L; float* S1 = (float*)Zg;
#pragma unroll 1
      for (int ch = 0; ch < L / 4096; ++ch) {
          const int n0 = 8 * tid + 4096 * ch;
          f32x4 a[4][2];
#pragma unroll
          for (int q = 0; q < 4; ++q) { a[q][0] = (f32x4){0.f, 0.f, 0.f, 0.f}; a[q][1] = (f32x4){0.f, 0.f, 0.f, 0.f}; }
          const bf16_t* hr = h3 + n0;
#pragma unroll 8
          for (int j = 0; j < 64; ++j) {
              const f32x4 wv = *(const f32x4*)(W4C + 4 * j); const u32x4 hb = *(const u32x4*)(hr + (size_t)j * L);
              const f32x4 h0 = {bflo(hb.x), bfhi(hb.x), bflo(hb.y), bfhi(hb.y)}, h1 = {bflo(hb.z), bfhi(hb.z), bflo(hb.w), bfhi(hb.w)};
#pragma unroll
              for (int q = 0; q < 4; ++q) { a[q][0] += h0 * wv[q]; a[q][1] += h1 * wv[q]; }
          }
#pragma unroll
          for (int h = 0; h < 2; ++h) { f32x4 dec;
#pragma unroll
              for (int e = 0; e < 4; ++e) dec[e] = expf(-((float)(n0 + 4 * h + e) / (float)(L - 1)) * adel);
              *(f32x4*)(HF + n0 + 4 * h) = a[0][h] * dec; *(f32x4*)(HBk + n0 + 4 * h) = a[1][h] * dec;
              *(f32x4*)(S1 + n0 + 4 * h) = a[2][h] * dec; *(f32x4*)(S1 + L + n0 + 4 * h) = a[3][h] * dec; }
      } }
#pragma unroll 1
    for (int o = 0; o < 2; ++o) {
        asm volatile("" : "+v"(tid));
        float* HF = (float*)D; float* HBk = HF + L;
        if (o == 1) {
#pragma unroll 2
            for (int i = 0; i < NE; ++i) { const int n = tid + 512 * i; HF[n] = ((const float*)Zg)[n]; HBk[n] = ((const float*)Zg)[L + n]; }
        }
        __syncthreads();
        float hfv[NE], hbv[NE];
#pragma unroll
        for (int k = 0; k < NE; ++k) { const int n = tid + 512 * k; hfv[k] = HF[n]; hbv[k] = n ? HBk[L - n] : 0.f; }
        __syncthreads();
        const float bo = hbias[o * 1024 + c];
        asm volatile("" : "+v"(tid));
        { c32 e[NE];
#pragma unroll
          for (int k = 0; k < NE; ++k) e[k] = mk(hfv[k] + hbv[k], 0.f);
          fft_head<LOG>(e, D, TW, tid);
          filt_last<LOG>(D, TW, Kb + (size_t)(o * 2 + 0) * L, bo, tid);
          __syncthreads();
          asm volatile("" : "+v"(tid));
          const c32 wt = T[tid << MS];
#pragma unroll
          for (int k = 0; k < NE; ++k) { const c32 w = cmul(wt, T[(512 * k) << MS]); const float d = hfv[k] - hbv[k]; e[k] = mk(d * w.x, d * w.y); }
          fft_head<LOG>(e, D, TW, tid);
          filt_last<LOG>(D, TW, Kb + (size_t)(o * 2 + 1) * L, bo, tid);
          __syncthreads(); }
    }
    const float inv2L = 1.0f / (float)(2 * L);
    u32x4 pf[L / 2048];
    stage_load<LOG>(uT + (size_t)c * NTOK + TOK0, pf, tid);
#pragma unroll 1
    for (int pr = 0; pr < NB / 2; ++pr) {
        const size_t tbase = (size_t)TOK0 + (size_t)(2 * pr) * L;
        c32 z[NE];
        { bf16_t* S = (bf16_t*)lds_raw;
          const float w0 = convw[c], w1 = convw[3072 + c], w2 = convw[6144 + c], bb = convb[c];
          stage_store<LOG>(pf, S, tid);
          __syncthreads();
#pragma unroll
          for (int k = 0; k < NE; ++k) { const int n = tid + 512 * k; z[k] = mk(sconvS(S + 8, n, w0, w1, w2, bb), sconvS(S + (L + 16) + 8, n, w0, w1, w2, bb)); } }
        __syncthreads();
#pragma unroll 1
        for (int o = 0; o < 2; ++o) {
            const c32* K0 = Kb + (size_t)(o * 2 + 0) * L; const c32* K1 = Kb + (size_t)(o * 2 + 1) * L;
            c32 e[NE], a[NE];
            asm volatile("" : "+v"(tid));
            const c32 wt = T[tid << MS];
#pragma unroll
            for (int k = 0; k < NE; ++k) e[k] = z[k];
            fft_head<LOG>(e, D, TW, tid);
            fusedK<LOG>(D, TW, K0, tid);
            fft_tail<LOG>(e, D, TW, tid);
#pragma unroll
            for (int k = 0; k < NE; ++k) a[k] = e[k];
            asm volatile("" : "+v"(tid));
            stage_load<LOG>(uT + (size_t)((o + 1) * 1024 + c) * NTOK + tbase, pf, tid);
#pragma unroll
            for (int k = 0; k < NE; ++k) e[k] = cmul(z[k], cmul(wt, T[(512 * k) << MS]));
            fft_head<LOG>(e, D, TW, tid);
            fusedK<LOG>(D, TW, K1, tid);
            fft_tail<LOG>(e, D, TW, tid);
            asm volatile("" : "+v"(tid));
            __syncthreads();
            { const int gc = (o + 1) * 1024 + c; bf16_t* S = (bf16_t*)lds_raw; bf16_t* Ys = (bf16_t*)(lds_raw + 36864);
              stage_store<LOG>(pf, S, tid);
              if (o == 1 && pr + 1 < NB / 2) stage_load<LOG>(uT + (size_t)c * NTOK + tbase + 2 * L, pf, tid);
              const float w0 = convw[gc], w1 = convw[3072 + gc], w2 = convw[6144 + gc], bb = convb[gc];
              __syncthreads();
#pragma unroll
              for (int k = 0; k < NE; ++k) { const int n = tid + 512 * k; const c32 d = cmulc(e[k], cmul(wt, T[(512 * k) << MS]));
                  z[k] = mk(sconvS(S + 8, n, w0, w1, w2, bb) * ((a[k].x + d.x) * inv2L), sconvS(S + (L + 16) + 8, n, w0, w1, w2, bb) * ((a[k].y + d.y) * inv2L));
                  if (o == 1) { Ys[n] = (bf16_t)(pk2(z[k].x, 0.f) & 0xffffu); Ys[L + n] = (bf16_t)(pk2(z[k].y, 0.f) & 0xffffu); } } }
            __syncthreads();
        }
        { bf16_t* y0 = yT + (size_t)c * NTOK + tbase; const bf16_t* Ys = (const bf16_t*)(lds_raw + 36864);
#pragma unroll
          for (int i = 0; i < L / 2048; ++i) { const int q = tid + 512 * i; *(u32x4*)(y0 + (size_t)q * 8) = *(const u32x4*)(Ys + q * 8); } }
        __syncthreads();
    }
}

template <int KR>
__device__ __forceinline__ void tr_read8(u32x2 (&v)[4][2], unsigned b0, unsigned b1, unsigned b2, unsigned b3) {
    asm volatile(
        "ds_read_b64_tr_b16 %0, %8 offset:%12\n\t"
        "ds_read_b64_tr_b16 %1, %8 offset:%13\n\t"
        "ds_read_b64_tr_b16 %2, %9 offset:%12\n\t"
        "ds_read_b64_tr_b16 %3, %9 offset:%13\n\t"
        "ds_read_b64_tr_b16 %4, %10 offset:%12\n\t"
        "ds_read_b64_tr_b16 %5, %10 offset:%13\n\t"
        "ds_read_b64_tr_b16 %6, %11 offset:%12\n\t"
        "ds_read_b64_tr_b16 %7, %11 offset:%13\n\t"
        "s_waitcnt lgkmcnt(0)"
        : "=&v"(v[0][0]), "=&v"(v[0][1]), "=&v"(v[1][0]), "=&v"(v[1][1]), "=&v"(v[2][0]), "=&v"(v[2][1]), "=&v"(v[3][0]), "=&v"(v[3][1])
        : "v"(b0), "v"(b1), "v"(b2), "v"(b3), "i"(KR * 8192), "i"(KR * 8192 + 2048)
        : "memory");
}
__device__ __forceinline__ void nat_item(const Params& p, int idx, unsigned char* lds_raw) {
    unsigned char* ws = p.ws;
    const bf16_t* qkv = (const bf16_t*)(ws + WS_QKV);
    bf16_t* ynat = (bf16_t*)((unsigned char*)p.out + DO_YNAT);
    const float* rpb = p.in[15];
    float* RP = (float*)(lds_raw + 122880);
    const int tid = threadIdx.x;
    int ib, head, rows, tok0;
    if (idx < 1024) { const int bg = idx >> 7, rem = idx & 127; ib = rem >> 4; head = rem & 15; rows = 64; tok0 = bg * 4096; }
    else { const int x = idx - 1024, bg = x >> 8, rem = x & 255; ib = rem >> 4; head = rem & 15; rows = 128; tok0 = NPROMPT + bg * 8192; }
    const int i0 = ib * 8, R0 = min(max(i0 - 4, 0), rows - 15);
#pragma unroll 5
    for (int it = 0; it < 15; ++it) {
        const int q = tid + 512 * it, tokl = q >> 3, ch = q & 7;
        const u32x4 v = *(const u32x4*)(qkv + (size_t)(tok0 + R0 * 64 + tokl) * 3072 + 2048 + head * 64 + ch * 8);
        *(u32x4*)(lds_raw + tokl * 128 + ((ch ^ (((tokl >> 1) & 3) << 1)) << 4)) = v;
    }
    if (tid < 465) RP[tid] = rpb[head * 465 + tid] * 1.4426950408889634f;
    __syncthreads();
    const int w = tid >> 6, lane = tid & 63, r = lane & 15, q = lane >> 4;
    const int jt = w & 3;
    const int sp = (jt == 0) ? 0 : (jt == 1) ? 8 : (jt == 2) ? 24 : 32;
    const int j = jt * 16 + r;
    const int cs = min(max(j - 8, 0), 48);
    unsigned vb0[4];
    { const int g = q, l16 = lane & 15, qq = l16 >> 2, pp = l16 & 3, key0 = sp + 4 * g + qq, swz = ((key0 >> 1) & 3) << 1;
      const unsigned lbase = (unsigned)(size_t)lds_raw + key0 * 128 + 8 * (pp & 1);
#pragma unroll
      for (int dt = 0; dt < 4; ++dt) vb0[dt] = lbase + ((((2 * dt + (pp >> 1)) ^ swz)) << 4); }
#pragma unroll 1
    for (int rnd = 0; rnd < 4; ++rnd) {
        const int i = i0 + (w >> 2) + 2 * rnd;
        const int rs = min(max(i - 4, 0), rows - 8);
        const size_t tq = (size_t)tok0 + (size_t)i * 64 + j;
        const bf16_t* qp = qkv + tq * 3072 + head * 64 + q * 8;
        const bf16x8 qf0 = *(const bf16x8*)qp, qf1 = *(const bf16x8*)(qp + 32);
        float sc[8][2][4];
        float sum = 0.f;
#pragma unroll
        for (int kr = 0; kr < 8; ++kr) {
            const float* bp = RP + (rs + kr - i + 7) * 31;
#pragma unroll
            for (int ct = 0; ct < 2; ++ct) {
                const bf16_t* kp = qkv + (size_t)(tok0 + (rs + kr) * 64 + sp + ct * 16 + r) * 3072 + 1024 + head * 64 + q * 8;
                const bf16x8 k0 = *(const bf16x8*)kp, k1 = *(const bf16x8*)(kp + 32);
                f32x4 s = {0.f, 0.f, 0.f, 0.f};
                s = __builtin_amdgcn_mfma_f32_16x16x32_bf16(k0, qf0, s, 0, 0, 0);
                s = __builtin_amdgcn_mfma_f32_16x16x32_bf16(k1, qf1, s, 0, 0, 0);
#pragma unroll
                for (int e = 0; e < 4; ++e) {
                    const int col = sp + ct * 16 + 4 * q + e; const bool valid = (col >= cs) && (col <= cs + 15);
                    const int co = min(max(col - j + 15, 0), 30);
                    const float pv = valid ? __builtin_amdgcn_exp2f(fminf(s[e] * (0.125f * 1.4426950408889634f) + bp[co], 80.0f)) : 0.f;
                    sc[kr][ct][e] = pv; sum += pv;
                }
            }
        }
        sum += __shfl_xor(sum, 16); sum += __shfl_xor(sum, 32);
        f32x4 acc[4];
#pragma unroll
        for (int dt = 0; dt < 4; ++dt) acc[dt] = (f32x4){0.f, 0.f, 0.f, 0.f};
        const unsigned roff = (unsigned)(rs - R0) * 8192u;
        const unsigned vb[4] = {vb0[0] + roff, vb0[1] + roff, vb0[2] + roff, vb0[3] + roff};
#define NAT_PV(KR) do { u32x2 vv[4][2]; tr_read8<KR>(vv, vb[0], vb[1], vb[2], vb[3]); \
        u32x4 pw; pw.x = pk2(sc[KR][0][0], sc[KR][0][1]); pw.y = pk2(sc[KR][0][2], sc[KR][0][3]); pw.z = pk2(sc[KR][1][0], sc[KR][1][1]); pw.w = pk2(sc[KR][1][2], sc[KR][1][3]); \
        const bf16x8 pb = __builtin_bit_cast(bf16x8, pw); \
        _Pragma("unroll") for (int dt = 0; dt < 4; ++dt) { u32x4 vw; vw.x = vv[dt][0].x; vw.y = vv[dt][0].y; vw.z = vv[dt][1].x; vw.w = vv[dt][1].y; \
            acc[dt] = __builtin_amdgcn_mfma_f32_16x16x32_bf16(__builtin_bit_cast(bf16x8, vw), pb, acc[dt], 0, 0, 0); } } while (0)
        NAT_PV(0); NAT_PV(1); NAT_PV(2); NAT_PV(3); NAT_PV(4); NAT_PV(5); NAT_PV(6); NAT_PV(7);
#undef NAT_PV
        const float inv = 1.0f / sum;
        bf16_t* op = ynat + tq * 1024 + head * 64 + 4 * q;
#pragma unroll
        for (int dt = 0; dt < 4; ++dt) { u32x2 o; o.x = pk2(acc[dt][0] * inv, acc[dt][1] * inv); o.y = pk2(acc[dt][2] * inv, acc[dt][3] * inv); *(u32x2*)(op + dt * 16) = o; }
    }
    __syncthreads();
}

__device__ __forceinline__ void norm_item(const Params& p, int item, unsigned char* lds_raw) {
    unsigned char* ws = p.ws;
    const bf16_t* yT = (const bf16_t*)((unsigned char*)p.out + DO_YT);
    const bf16_t* ynat = (const bf16_t*)((unsigned char*)p.out + DO_YNAT);
    bf16_t* mix = (bf16_t*)(ws + WS_MIX);
    const float* ghy = p.in[16]; const float* gnat = p.in[17];
    bf16_t* Tl = (bf16_t*)lds_raw;
    const int tid = threadIdx.x, lane = tid & 63, w = tid >> 6;
    const int tokb = item * 64;
    u32x4 na[8][2];
#pragma unroll
    for (int tt = 0; tt < 8; ++tt) { const u32x4* src = (const u32x4*)(ynat + ((size_t)tokb + w * 8 + tt) * 1024); na[tt][0] = src[lane]; na[tt][1] = src[lane + 64]; }
#pragma unroll 4
    for (int it = 0; it < 16; ++it) {
        const int q = tid + 512 * it, c = q >> 3, ch = q & 7;
        const u32x4 v = *(const u32x4*)(yT + (size_t)c * NTOK + tokb + ch * 8);
        unsigned* dst = (unsigned*)(Tl + c * 66 + ch * 8);
        dst[0] = v.x; dst[1] = v.y; dst[2] = v.z; dst[3] = v.w;
    }
    float gh[16];
#pragma unroll
    for (int jj = 0; jj < 8; ++jj) { gh[2 * jj] = ghy[2 * lane + 128 * jj]; gh[2 * jj + 1] = ghy[2 * lane + 128 * jj + 1]; }
    f32x4 gn[2][2];
#pragma unroll
    for (int h = 0; h < 2; ++h) { gn[h][0] = *(const f32x4*)(gnat + h * 512 + lane * 8); gn[h][1] = *(const f32x4*)(gnat + h * 512 + lane * 8 + 4); }
    __syncthreads();
#pragma unroll
    for (int tt = 0; tt < 8; ++tt) {
        const int tl = w * 8 + tt; const size_t tok = (size_t)tokb + tl;
        float v[16]; float ss = 0.f;
#pragma unroll
        for (int jj = 0; jj < 8; ++jj) { const int c = 2 * lane + 128 * jj; v[2 * jj] = bf2f(Tl[c * 66 + tl]); v[2 * jj + 1] = bf2f(Tl[(c + 1) * 66 + tl]); ss += v[2 * jj] * v[2 * jj] + v[2 * jj + 1] * v[2 * jj + 1]; }
        ss = wave_sum(ss);
        const float rstd = 1.0f / sqrtf(ss * (1.0f / 1024.0f) + EPS);
        bf16_t* mo = mix + tok * PX;
#pragma unroll
        for (int jj = 0; jj < 8; ++jj) *(unsigned*)(mo + 2 * lane + 128 * jj) = pk2(v[2 * jj] * rstd * gh[2 * jj], v[2 * jj + 1] * rstd * gh[2 * jj + 1]);
        float f[16]; float s2 = 0.f;
#pragma unroll
        for (int h = 0; h < 2; ++h) { const u32x4 a = na[tt][h]; f[h * 8 + 0] = bflo(a.x); f[h * 8 + 1] = bfhi(a.x); f[h * 8 + 2] = bflo(a.y); f[h * 8 + 3] = bfhi(a.y);
            f[h * 8 + 4] = bflo(a.z); f[h * 8 + 5] = bfhi(a.z); f[h * 8 + 6] = bflo(a.w); f[h * 8 + 7] = bfhi(a.w); }
#pragma unroll
        for (int e = 0; e < 16; ++e) s2 += f[e] * f[e];
        s2 = wave_sum(s2);
        const float r2 = 1.0f / sqrtf(s2 * (1.0f / 1024.0f) + EPS);
        u32x4* dst = (u32x4*)(mo + 1024);
#pragma unroll
        for (int h = 0; h < 2; ++h) { const f32x4 g0 = gn[h][0], g1 = gn[h][1];
            u32x4 o; o.x = pk2(f[h * 8 + 0] * r2 * g0[0], f[h * 8 + 1] * r2 * g0[1]); o.y = pk2(f[h * 8 + 2] * r2 * g0[2], f[h * 8 + 3] * r2 * g0[3]);
            o.z = pk2(f[h * 8 + 4] * r2 * g1[0], f[h * 8 + 5] * r2 * g1[1]); o.w = pk2(f[h * 8 + 6] * r2 * g1[2], f[h * 8 + 7] * r2 * g1[3]);
            dst[lane + 64 * h] = o; }
    }
    __syncthreads();
}

#define XB_TMO      128
#define XB_XCNT(j)  (256  + 64 * (j))
#define XB_XSUB(j)  (1280 + 64 * (j))
#define XB_XGEN(j)  (2304 + 64 * (j))
#define XB_TOP      3328
#define XB_TOPGEN   3392
#define XCD_BAR_WORDS 3456
#define XB_SPIN_CAP (1u << 18)

__device__ __forceinline__ unsigned xb_ld(unsigned* p)              { return __hip_atomic_load(p, __ATOMIC_RELAXED, __HIP_MEMORY_SCOPE_AGENT); }
__device__ __forceinline__ unsigned xb_add(unsigned* p, unsigned v) { return __hip_atomic_fetch_add(p, v, __ATOMIC_RELAXED, __HIP_MEMORY_SCOPE_AGENT); }
__device__ __forceinline__ unsigned xb_xcc_id() { return (unsigned)__builtin_amdgcn_s_getreg((3 << 11) | 20) & 0xFu; }
#define XB_SPIN(cond, bar) do { unsigned _sp = 0; while (cond) { __builtin_amdgcn_s_sleep(1); \
    if ((++_sp & 255u) == 0u) { if (xb_ld(&(bar)[XB_TMO])) break; if (_sp > XB_SPIN_CAP) { atomicAdd(&(bar)[XB_TMO], 1u); break; } } } } while (0)

struct XcdBarrier {
    unsigned* bar; unsigned x;
    volatile LAS unsigned* st;
};

__device__ __forceinline__ XcdBarrier xcd_barrier_post(unsigned* bar, volatile LAS unsigned* st) {
    XcdBarrier b; b.bar = bar; b.x = xb_xcc_id(); b.st = st;
    if (threadIdx.x == 0) (void)xb_add(&bar[XB_XCNT(b.x)], 1u);
    return b;
}
__device__ __forceinline__ void xcd_barrier_complete(unsigned* bar, unsigned x, unsigned& nloc, unsigned& nx) {
    const unsigned G = gridDim.x * gridDim.y * gridDim.z;
    unsigned sum, cnt, mine, sp = 0u;
    for (;;) {
        sum = 0u; cnt = 0u; mine = 0u;
#pragma unroll
        for (unsigned j = 0; j < 16; ++j) { const unsigned c = xb_ld(&bar[XB_XCNT(j)]); sum += c; cnt += (c > 0u) ? 1u : 0u; mine = (j == x) ? c : mine; }
        if (sum == G) break;
        __builtin_amdgcn_s_sleep(1);
        if ((++sp & 255u) == 0u) { if (xb_ld(&bar[XB_TMO])) break; if (sp > XB_SPIN_CAP) { atomicAdd(&bar[XB_TMO], 1u); break; } }
    }
    nloc = mine > 0u ? mine : 1u; nx = cnt > 0u ? cnt : 1u;
}

__device__ __forceinline__ void xcd_barrier(const XcdBarrier& b) {
    asm volatile("s_waitcnt vmcnt(0)" ::: "memory");
    __syncthreads();
    if (threadIdx.x == 0) {
        unsigned* bar = b.bar;
        __builtin_amdgcn_s_waitcnt(0);
        unsigned nloc = b.st[0], nx = b.st[1];
        if (nloc == 0u) { xcd_barrier_complete(bar, b.x, nloc, nx); b.st[0] = nloc; b.st[1] = nx; }
        const unsigned old = xb_add(&bar[XB_XSUB(b.x)], 1u);
        const unsigned gen = old / nloc;
        if (old + 1u == (gen + 1u) * nloc) {
            __builtin_amdgcn_fence(__ATOMIC_RELEASE, "agent");
            asm volatile("s_waitcnt vmcnt(0)" ::: "memory");
            const unsigned og = xb_add(&bar[XB_TOP], 1u);
            const unsigned tg = og / nx;
            if (og + 1u == (tg + 1u) * nx) xb_add(&bar[XB_TOPGEN], 1u);
            else XB_SPIN(xb_ld(&bar[XB_TOPGEN]) == tg, bar);
            __builtin_amdgcn_fence(__ATOMIC_ACQUIRE, "agent");
            xb_add(&bar[XB_XGEN(b.x)], 1u);
            asm volatile("s_waitcnt vmcnt(0)" ::: "memory");
        } else {
            XB_SPIN(xb_ld(&bar[XB_XGEN(b.x)]) == gen, bar);
            __builtin_amdgcn_fence(__ATOMIC_ACQUIRE, "agent");
            asm volatile("s_waitcnt vmcnt(0)" ::: "memory");
        }
    }
    __syncthreads();
}

__global__ void __launch_bounds__(512, 2) fwd_kernel(Params p) {
    extern __shared__ __attribute__((aligned(16))) unsigned char lds_raw[];
    cg::grid_group grid = cg::this_grid();
    LAS unsigned char* lds = (LAS unsigned char*)lds_raw;
    unsigned char* ws = p.ws;
    const int lo = p.ph_lo, hi = p.ph_hi;
    const int G = gridDim.x, bx = blockIdx.x;
#ifndef PHMASK
#define PHMASK 0xFFFFFF
#endif
#define IN(k) (((PHMASK >> (k)) & 1) && lo <= (k) && (k) < hi)
    volatile LAS unsigned* bst = (volatile LAS unsigned*)(lds + (LDS_BYTES - 64));
    if (threadIdx.x < 2) bst[threadIdx.x] = 0u;
    __syncthreads();
    XcdBarrier xbar = xcd_barrier_post((unsigned*)(ws + WS_BAR), bst);
#define SEAM(k) do { if ((k) + 1 < hi) { if ((k) == 0) grid.sync(); else xcd_barrier(xbar); } } while (0)
    bf16_t* xb = (bf16_t*)((unsigned char*)p.out + DO_XB);
    float* rstdx = (float*)(ws + WS_RSTDX); float* ssh = (float*)(ws + WS_SSH); float* ssf = (float*)(ws + WS_SSF);

    if (IN(0)) { phase_prep(p, lds_raw); SEAM(0); }
    if (IN(1)) {
        { pg8::Gemm g{(const bf16_t*)(ws + WS_WIN), xb, 3072, NTOK, DM}; pg8::StaticOrder S; S.init(3072, NTOK, G, bx);
          EpiUT E{(bf16_t*)(ws + WS_UT), rstdx};
          pg8::gemm_phase<EpiUT, pg8::StaticOrder, true, true>(lds, g, S, E); }
        { pg8::Gemm g{xb, (const bf16_t*)(ws + WS_WIN) + (size_t)3072 * PX, NTOK, 3072, DM}; pg8::StaticOrder S; S.init(NTOK, 3072, G, bx);
          EpiQKV E{(bf16_t*)(ws + WS_QKV), rstdx};
          pg8::gemm_phase<EpiQKV, pg8::StaticOrder, true, true>(lds, g, S, E); }
        SEAM(1);
    }
    if (IN(2)) {
#ifndef NO_NAT
        for (int it = bx; it < 2048; it += G) nat_item(p, it, lds_raw);
#endif
#ifndef NO_HY12
        for (int it = bx; it < 1024; it += G) hyena_item<12>(p, it, lds_raw, it == bx);
#endif
#ifndef NO_HY13
        for (int it = bx; it < 1024; it += G) hyena_item<13>(p, it, lds_raw, it == bx);
#endif
        SEAM(2);
    }
    if (IN(3)) { for (int it = bx; it < 1024; it += G) norm_item(p, it, lds_raw); SEAM(3); }
    if (IN(4)) {
        pg8::Gemm g{(const bf16_t*)(ws + WS_MIX), (const bf16_t*)(ws + WS_WOUT), NTOK, DM, DM}; pg8::StaticOrder S; S.init(NTOK, DM, G, bx);
        EpiH E{p.in[0], p.in[1], p.out, (bf16_t*)(ws + WS_HB), ssh};
        pg8::gemm_phase<EpiH, pg8::StaticOrder, true, true>(lds, g, S, E);
        SEAM(4);
    }
#pragma unroll 1
    for (int ck = 0; ck < N_CHUNK; ++ck) {
        if (IN(5 + 2 * ck)) {
            pg8::Gemm g{(const bf16_t*)(ws + WS_HB) + (size_t)ck * FFN_CHUNK * PX, (const bf16_t*)(ws + WS_WUP), FFN_CHUNK, DFF, DM}; pg8::StaticOrder S; S.init(FFN_CHUNK, DFF, G, bx);
            EpiUp E{(bf16_t*)(ws + WS_HID), ssh + ck * FFN_CHUNK};
            pg8::gemm_phase<EpiUp, pg8::StaticOrder, true, true>(lds, g, S, E);
            SEAM(5 + 2 * ck);
        }
        if (IN(6 + 2 * ck)) {
            pg8::Gemm g{(const bf16_t*)(ws + WS_HID), (const bf16_t*)(ws + WS_WDN), FFN_CHUNK, DM, DFF}; pg8::StaticOrder S; S.init(FFN_CHUNK, DM, G, bx);
            EpiDown E{(bf16_t*)(ws + WS_HB) + (size_t)ck * FFN_CHUNK * PX, ssf + ck * FFN_CHUNK, ssh + ck * FFN_CHUNK};
            pg8::gemm_phase<EpiDown, pg8::StaticOrder, true, true>(lds, g, S, E);
            SEAM(6 + 2 * ck);
        }
    }
    if (IN(N_PHASES - 1)) {
        const int tid = threadIdx.x, lane = tid & 63, gw = bx * 8 + (tid >> 6), NGW = G * 8;
        const f32x4* gf = (const f32x4*)p.in[22];
        const bf16_t* h2 = (const bf16_t*)(ws + WS_HB);
        f32x4 gg[4][2];
#pragma unroll
        for (int j = 0; j < 4; ++j) { gg[j][0] = gf[2 * (lane + 64 * j)]; gg[j][1] = gf[2 * (lane + 64 * j) + 1]; }
        for (int row = gw; row < NTOK; row += 4 * NGW) {
            u32x4 hw[4][4]; float rs[4];
#pragma unroll
            for (int r = 0; r < 4; ++r) { const int rr = row + r * NGW < NTOK ? row + r * NGW : row; const u32x4* hr = (const u32x4*)(h2 + (size_t)rr * PX);
#pragma unroll
                for (int j = 0; j < 4; ++j) hw[r][j] = hr[lane + 64 * j];
                rs[r] = 1.0f / sqrtf(ssf[rr] * (1.0f / DM) + EPS); }
#pragma unroll
            for (int r = 0; r < 4; ++r) { const int rr = row + r * NGW < NTOK ? row + r * NGW : row; f32x4* o = (f32x4*)(p.out + (size_t)rr * DM);
#pragma unroll
                for (int j = 0; j < 4; ++j) { const u32x4 h = hw[r][j];
                    const f32x4 x0 = {bflo(h.x), bfhi(h.x), bflo(h.y), bfhi(h.y)}, x1 = {bflo(h.z), bfhi(h.z), bflo(h.w), bfhi(h.w)};
                    o[2 * (lane + 64 * j)] = x0 * rs[r] * gg[j][0]; o[2 * (lane + 64 * j) + 1] = x1 * rs[r] * gg[j][1]; } }
        }
    }
#undef IN
#undef SEAM
}

extern "C" void kernel_launch(void* const* d_in, const int* in_sizes, int n_in, void* d_out, int out_size, void* d_ws, size_t ws_size, hipStream_t stream) {
    static int grid = 0;
    if (grid == 0) {
        int dev = 0, cus = 0, per_cu = 0;
        hipGetDevice(&dev);
        hipDeviceGetAttribute(&cus, hipDeviceAttributeMultiprocessorCount, dev);
        hipFuncSetAttribute((const void*)fwd_kernel, hipFuncAttributeMaxDynamicSharedMemorySize, LDS_BYTES);
        hipOccupancyMaxActiveBlocksPerMultiprocessor(&per_cu, (const void*)fwd_kernel, 512, LDS_BYTES);
        (void)hipGetLastError();
        grid = cus > 0 ? cus : 256; if (grid > 256) grid = 256;
        if (n_in != 23 || ws_size < WS_END) { fprintf(stderr, "kernel_launch: unexpected n_in %d / ws_size %zu (need %zu)\n", n_in, ws_size, (size_t)WS_END); }
        fprintf(stderr, "kernel_launch: grid %d, occupancy query %d/CU, ws %zu\n", grid, per_cu, ws_size);
    }
    Params p{};
    for (int i = 0; i < 23; ++i) p.in[i] = (const float*)d_in[i];
    p.out = (float*)d_out; p.ws = (unsigned char*)d_ws; p.ph_lo = 0; p.ph_hi = N_PHASES;
    (void)hipMemsetAsync((unsigned char*)d_ws + WS_BAR, 0, XCD_BAR_WORDS * sizeof(unsigned), stream);
    void* args[] = {&p};
    hipError_t e = hipLaunchCooperativeKernel((const void*)fwd_kernel, dim3(grid), dim3(512), args, LDS_BYTES, stream);
    if (e != hipSuccess) fprintf(stderr, "cooperative launch failed: %s (grid %d)\n", hipGetErrorString(e), grid);
}
```
